# Optimizing an MI355X kernel written in HIP

```python
import math
import jax, jax.numpy as jnp
from jax import lax
import numpy as np

D_MODEL = 1024
BATCH = 8
SEQ = 4096
DEPTH = 1

HEAD_DIM = 64
BLOCK = 128
WINDOW = 128
A_Q_HEADS = 8
A_KV_HEADS = 2
A_GROUP = A_Q_HEADS // A_KV_HEADS
B_HEADS = 8
N_BRANCHES = 2
ROPE_THETA = 10000.0
RMS_EPS = 1e-6
_ffn_raw = (8 * D_MODEL + 2) // 3
D_FF = ((_ffn_raw + 255) // 256) * 256

A_Q_W = A_Q_HEADS * HEAD_DIM
A_KV_W = A_KV_HEADS * HEAD_DIM
B_W = B_HEADS * HEAD_DIM
GATE_W = N_BRANCHES * D_MODEL
IN_SPLITS = [A_Q_W, A_KV_W, A_KV_W, B_W, B_W, B_W, B_HEADS, GATE_W]
IN_OFFSETS = list(np.cumsum(IN_SPLITS)[:-1])
IN_W = int(sum(IN_SPLITS))
N_ADA = 6

kernel_name = "hybrid_swa_sink_fox_gated_block"


def rms_norm(x, g):
    xf = x.astype(jnp.float32)
    y = xf * lax.rsqrt(jnp.mean(xf * xf, axis=-1, keepdims=True) + RMS_EPS)
    return (y * g.astype(jnp.float32)).astype(x.dtype)


def rope(x, positions):
    dh = x.shape[-1]
    inv_freq = 1.0 / (ROPE_THETA ** (jnp.arange(0, dh, 2, dtype=jnp.float32) / dh))
    ang = positions.astype(jnp.float32)[..., None] * inv_freq
    cos = jnp.cos(ang)[:, :, None, :]
    sin = jnp.sin(ang)[:, :, None, :]
    xf = x.astype(jnp.float32)
    x1, x2 = xf[..., : dh // 2], xf[..., dh // 2:]
    out = jnp.concatenate([x1 * cos - x2 * sin, x2 * cos + x1 * sin], axis=-1)
    return out.astype(x.dtype)


def sliding_window_gqa_sinks(q, k, v, sinks):
    B, S, _, dh = q.shape
    nb = S // BLOCK
    scale = 1.0 / math.sqrt(dh)
    qb = q.reshape(B, nb, BLOCK, A_KV_HEADS, A_GROUP, dh)
    pad = ((0, 0), (BLOCK, 0), (0, 0), (0, 0))
    kp = jnp.pad(k, pad).reshape(B, nb + 1, BLOCK, A_KV_HEADS, dh)
    vp = jnp.pad(v, pad).reshape(B, nb + 1, BLOCK, A_KV_HEADS, dh)
    kb = jnp.concatenate([kp[:, :-1], kp[:, 1:]], axis=2)
    vb = jnp.concatenate([vp[:, :-1], vp[:, 1:]], axis=2)
    s = jnp.einsum('bnqhgd,bnkhd->bnhgqk', qb, kb).astype(jnp.float32) * scale
    q_loc = jnp.arange(BLOCK) + BLOCK
    k_loc = jnp.arange(2 * BLOCK)
    rel = q_loc[:, None] - k_loc[None, :]
    band = (rel >= 0) & (rel < WINDOW)
    k_abs = jnp.arange(nb)[:, None] * BLOCK + k_loc[None, :] - BLOCK
    valid = band[None, :, :] & (k_abs >= 0)[:, None, :]
    s = jnp.where(valid[None, :, None, None], s, -jnp.inf)
    sink = sinks.astype(jnp.float32).reshape(1, 1, A_KV_HEADS, A_GROUP, 1, 1)
    m = jnp.maximum(jnp.max(s, axis=-1, keepdims=True), sink)
    p = jnp.exp(s - m)
    denom = jnp.sum(p, axis=-1, keepdims=True) + jnp.exp(sink - m)
    p = p / denom
    o = jnp.einsum('bnhgqk,bnkhd->bnqhgd', p, vb.astype(jnp.float32))
    return o.reshape(B, S, A_Q_HEADS * dh)


def forgetting_attention(q, k, v, log_f):
    B, S, H, dh = q.shape
    nb = S // BLOCK
    scale = 1.0 / math.sqrt(dh)
    cum = lax.cumsum(log_f, axis=1)
    cum_k = jnp.transpose(cum, (0, 2, 1))
    k_pos = jnp.arange(S)
    vf = v.astype(jnp.float32)

    def one_block(i):
        start = i * BLOCK
        qi = lax.dynamic_slice_in_dim(q, start, BLOCK, axis=1)
        ci = lax.dynamic_slice_in_dim(cum, start, BLOCK, axis=1)
        s = jnp.einsum('bqhd,bkhd->bhqk', qi, k).astype(jnp.float32) * scale
        s = s + jnp.transpose(ci, (0, 2, 1))[..., None] - cum_k[:, :, None, :]
        q_pos = start + jnp.arange(BLOCK)
        s = jnp.where((k_pos[None, :] <= q_pos[:, None])[None, None], s, -jnp.inf)
        p = jax.nn.softmax(s, axis=-1)
        return jnp.einsum('bhqk,bkhd->bqhd', p, vf)

    o = lax.map(one_block, jnp.arange(nb))
    return jnp.transpose(o, (1, 0, 2, 3, 4)).reshape(B, S, H * dh)


def setup_inputs(seed: int = 0) -> dict:
    key = jax.random.key(seed)
    ks = jax.random.split(key, 20)
    f32 = jnp.float32
    nrm = lambda k, shape, s: jax.random.normal(k, shape, f32) * s
    x = nrm(ks[0], (BATCH, SEQ, D_MODEL), 1.0)
    c = nrm(ks[1], (BATCH, D_MODEL), 1.0)
    positions = jnp.broadcast_to(jnp.arange(SEQ, dtype=jnp.int32), (BATCH, SEQ))
    w_ada = nrm(ks[2], (DEPTH, D_MODEL, N_ADA * D_MODEL), 0.5 * D_MODEL ** -0.5)
    b_ada = nrm(ks[3], (DEPTH, N_ADA * D_MODEL), 0.01)
    g_pre_mix = 1.0 + nrm(ks[4], (DEPTH, D_MODEL), 0.05)
    g_post_mix = 1.0 + nrm(ks[5], (DEPTH, D_MODEL), 0.05)
    w_in = nrm(ks[6], (DEPTH, D_MODEL, IN_W), D_MODEL ** -0.5)
    b_f = 1.0 + nrm(ks[7], (DEPTH, B_HEADS), 0.1)
    sinks = nrm(ks[8], (DEPTH, A_Q_HEADS), 0.5)
    w_branch_a = nrm(ks[9], (DEPTH, A_Q_W, D_MODEL), A_Q_W ** -0.5)
    w_branch_b = nrm(ks[10], (DEPTH, B_W, D_MODEL), B_W ** -0.5)
    w_out = nrm(ks[11], (DEPTH, D_MODEL, D_MODEL), D_MODEL ** -0.5)
    g_pre_ffn = 1.0 + nrm(ks[12], (DEPTH, D_MODEL), 0.05)
    g_post_ffn = 1.0 + nrm(ks[13], (DEPTH, D_MODEL), 0.05)
    w_ffn_in = nrm(ks[14], (DEPTH, D_MODEL, 2 * D_FF), D_MODEL ** -0.5)
    w_ffn_out = nrm(ks[15], (DEPTH, D_FF, D_MODEL), D_FF ** -0.5)
    return {"x": x, "c": c, "positions": positions, "w_ada": w_ada, "b_ada": b_ada,
            "g_pre_mix": g_pre_mix, "g_post_mix": g_post_mix, "w_in": w_in, "b_f": b_f,
            "sinks": sinks, "w_branch_a": w_branch_a, "w_branch_b": w_branch_b,
            "w_out": w_out, "g_pre_ffn": g_pre_ffn, "g_post_ffn": g_post_ffn,
            "w_ffn_in": w_ffn_in, "w_ffn_out": w_ffn_out}


def reference(x, c, positions, w_ada, b_ada, g_pre_mix, g_post_mix, w_in, b_f, sinks,
              w_branch_a, w_branch_b, w_out, g_pre_ffn, g_post_ffn, w_ffn_in, w_ffn_out):
    B, S, D = x.shape
    for l in range(DEPTH):
        ada = (c @ w_ada[l] + b_ada[l]).reshape(B, N_ADA, D)[:, :, None, :]
        shift_m, scale_m, gate_m = ada[:, 0], ada[:, 1], ada[:, 2]
        shift_f, scale_f, gate_f = ada[:, 3], ada[:, 4], ada[:, 5]

        h = rms_norm(x, g_pre_mix[l]) * (1.0 + scale_m) + shift_m
        proj = h @ w_in[l]
        qa, ka, va, qb, kb, vb, f_logit, gate_logit = jnp.split(proj, IN_OFFSETS, axis=-1)
        qa = rope(qa.reshape(B, S, A_Q_HEADS, HEAD_DIM), positions)
        ka = rope(ka.reshape(B, S, A_KV_HEADS, HEAD_DIM), positions)
        va = va.reshape(B, S, A_KV_HEADS, HEAD_DIM)
        o_a = sliding_window_gqa_sinks(qa, ka, va, sinks[l]).astype(x.dtype)

        log_f = jax.nn.log_sigmoid((f_logit + b_f[l]).astype(jnp.float32))
        o_b = forgetting_attention(qb.reshape(B, S, B_HEADS, HEAD_DIM),
                                   kb.reshape(B, S, B_HEADS, HEAD_DIM),
                                   vb.reshape(B, S, B_HEADS, HEAD_DIM), log_f).astype(x.dtype)

        gates = jax.nn.sigmoid(gate_logit).reshape(B, S, N_BRANCHES, D)
        merged = gates[:, :, 0] * (o_a @ w_branch_a[l]) + gates[:, :, 1] * (o_b @ w_branch_b[l])
        y = merged @ w_out[l]
        x = x + gate_m * rms_norm(y, g_post_mix[l])

        h = rms_norm(x, g_pre_ffn[l]) * (1.0 + scale_f) + shift_f
        gu = h @ w_ffn_in[l]
        g_part, u_part = gu[..., :D_FF], gu[..., D_FF:]
        y = (jax.nn.silu(g_part) * u_part) @ w_ffn_out[l]
        x = x + gate_f * rms_norm(y, g_post_ffn[l])
    return x
```

```cpp
#include <hip/hip_runtime.h>
#include <hip/hip_cooperative_groups.h>
#include <cstdio>
#include <cstdint>
#include <cmath>
namespace cg = cooperative_groups;
namespace pg8 {
#define PG8_LAS __attribute__((address_space(3)))
typedef unsigned short bf16_t;
typedef short bf16x8 __attribute__((ext_vector_type(8)));
typedef float f32x4 __attribute__((ext_vector_type(4)));
typedef unsigned u32x4 __attribute__((ext_vector_type(4)));
constexpr int BM = 256, BK = 64, HALF = 128, HTB = HALF * BK * 2  , STAGE_BYTES = 8 * HTB, NXCD = 8, WGM = 8;

__host__ __device__ __forceinline__ int lds_byte(int r, int c) { const int st = (r >> 4) * 2 + (c >> 5), rr = r & 15, cc = c & 31, ob = rr * 64 + cc * 2; return st * 1024 + (ob ^ (((ob >> 9) & 1) << 5)); }
__host__ __device__ __forceinline__ void stage_rc(int b, int& R, int& C) { const int st = b / 1024, sb = b % 1024, swz = sb ^ (((sb >> 9) & 1) << 5); R = (st >> 1) * 16 + swz / 64; C = (st & 1) * 32 + (swz % 64) / 2; }
__host__ __device__ __forceinline__ int perm32(int rho) { const int n = rho >> 4, i = rho & 15; return 8 * (i >> 2) + 4 * n + (i & 3); }

struct Unit { int pm, pn; };
struct Gemm { const bf16_t* A; const bf16_t* Bt; int M, N, K; };

struct StaticOrder {
    int nM, nN, nwg, G, c;
    __host__ __device__ void init(int M, int N, int G_, int c_) { nM = M / BM; nN = N / BM; nwg = nM * nN; G = G_; c = c_; }
    __host__ __device__ bool next(int i, Unit& u) const {
        const long L = (long)i * G + c; if (L >= nwg) return false;
        int wgid = (int)L; { const int q = nwg / NXCD, r = nwg % NXCD, xcd = wgid % NXCD, off = wgid / NXCD; wgid = (xcd < r ? xcd * (q + 1) : r * (q + 1) + (xcd - r) * q) + off; }
        const int nig = WGM * nN, gid = wgid / nig, fm = gid * WGM, gsz = (nM - fm) < WGM ? (nM - fm) : WGM;
        u.pm = fm + ((wgid % nig) % gsz); u.pn = (wgid % nig) / gsz; return true;
    }
    __device__ __forceinline__ void a_ready(const Unit&) const {}
    __device__ __forceinline__ void done(const Unit&) const {}
};
__device__ __forceinline__ unsigned cvt_pk_bf16(float lo, float hi) { unsigned r; asm volatile("v_cvt_pk_bf16_f32 %0, %1, %2" : "=v"(r) : "v"(lo), "v"(hi)); return r; }
typedef float f32x2 __attribute__((ext_vector_type(2)));
typedef unsigned u32x2 __attribute__((ext_vector_type(2)));
constexpr int PROJ_W = 4352;
constexpr float QSCALE = 0.125f * 1.4426950408889634f;
__device__ __forceinline__ float sigmoidf_(float v) { return 1.0f / (1.0f + __expf(-v)); }

struct EpiProj {
    static constexpr bool PERM = true, AFTER_DRAIN = false;
    bf16_t* P; const float* cs; const float* sn;
    __device__ __forceinline__ void operator()(const f32x4 (&acc)[2][2][4][2], const Unit& u, int wr, int wc, int fr, int fq) const {
        const int row0 = u.pm * BM + wr * 64 + fr;
#pragma unroll
        for (int bj = 0; bj < 2; ++bj) {
            const int ht = u.pn * 2 + bj;
            if (ht < 5) {
                const float sc = ht < 4 ? QSCALE : 1.0f;
                const int g4 = 4 * (4 * (wc & 1) + fq);
                const int cb = ht * 128 + (wc >> 1) * 64 + g4;
#pragma unroll
                for (int ai = 0; ai < 2; ++ai)
#pragma unroll
                    for (int m = 0; m < 4; ++m) {
                        const int row = row0 + ai * HALF + m * 16;
                        const f32x4 c = *(const f32x4*)(cs + (size_t)row * 32 + g4), s = *(const f32x4*)(sn + (size_t)row * 32 + g4);
                        const f32x4 x1 = acc[ai][bj][m][0], x2 = acc[ai][bj][m][1];
                        const f32x4 o1 = (x1 * c - x2 * s) * sc, o2 = (x2 * c + x1 * s) * sc;
                        u32x2 w1, w2; w1.x = cvt_pk_bf16(o1[0], o1[1]); w1.y = cvt_pk_bf16(o1[2], o1[3]); w2.x = cvt_pk_bf16(o2[0], o2[1]); w2.y = cvt_pk_bf16(o2[2], o2[3]);
                        bf16_t* rp = P + (size_t)row * PROJ_W + cb;
                        *(u32x2*)rp = w1; *(u32x2*)(rp + 32) = w2;
                    }
            } else {
                const int mode = (ht >= 18) ? 2 : ((ht >= 6 && ht < 10) ? 1 : 0);
                const float sc = mode == 1 ? QSCALE : 1.0f;
                const int col0 = ht * 128 + wc * 32 + 8 * fq;
#pragma unroll
                for (int ai = 0; ai < 2; ++ai)
#pragma unroll
                    for (int m = 0; m < 4; ++m) {
                        const int row = row0 + ai * HALF + m * 16;
                        f32x4 v0 = acc[ai][bj][m][0], v1 = acc[ai][bj][m][1];
                        if (mode == 2) {
#pragma unroll
                            for (int j = 0; j < 4; ++j) { v0[j] = sigmoidf_(v0[j]); v1[j] = sigmoidf_(v1[j]); }
                        } else { v0 = v0 * sc; v1 = v1 * sc; }
                        u32x4 w; w.x = cvt_pk_bf16(v0[0], v0[1]); w.y = cvt_pk_bf16(v0[2], v0[3]); w.z = cvt_pk_bf16(v1[0], v1[1]); w.w = cvt_pk_bf16(v1[2], v1[3]);
                        *(u32x4*)(P + (size_t)row * PROJ_W + col0) = w;
                    }
            }
        }
    }
};
__device__ __forceinline__ float bf_lo(unsigned w) { return __uint_as_float(w << 16); }
__device__ __forceinline__ float bf_hi(unsigned w) { return __uint_as_float(w & 0xffff0000u); }
template <bool SECOND> struct EpiBranch {
    static constexpr bool PERM = true, AFTER_DRAIN = false;
    bf16_t* O; const bf16_t* G;
    __device__ __forceinline__ void operator()(const f32x4 (&acc)[2][2][4][2], const Unit& u, int wr, int wc, int fr, int fq) const {
        const int row0 = u.pm * BM + wr * 64 + fr, col0 = u.pn * BM + wc * 32 + 8 * fq;
#pragma unroll
        for (int ai = 0; ai < 2; ++ai)
#pragma unroll
            for (int m = 0; m < 4; ++m) {
                const int row = row0 + ai * HALF + m * 16;
#pragma unroll
                for (int bj = 0; bj < 2; ++bj) {
                    const int col = col0 + bj * HALF;
                    const u32x4 g = *(const u32x4*)(G + (size_t)row * PROJ_W + col);
                    f32x4 v0 = acc[ai][bj][m][0], v1 = acc[ai][bj][m][1];
                    v0[0] *= bf_lo(g.x); v0[1] *= bf_hi(g.x); v0[2] *= bf_lo(g.y); v0[3] *= bf_hi(g.y);
                    v1[0] *= bf_lo(g.z); v1[1] *= bf_hi(g.z); v1[2] *= bf_lo(g.w); v1[3] *= bf_hi(g.w);
                    bf16_t* op = O + (size_t)row * 1024 + col;
                    if (SECOND) { const u32x4 p = *(const u32x4*)op;
                        v0[0] += bf_lo(p.x); v0[1] += bf_hi(p.x); v0[2] += bf_lo(p.y); v0[3] += bf_hi(p.y);
                        v1[0] += bf_lo(p.z); v1[1] += bf_hi(p.z); v1[2] += bf_lo(p.w); v1[3] += bf_hi(p.w); }
                    u32x4 w; w.x = cvt_pk_bf16(v0[0], v0[1]); w.y = cvt_pk_bf16(v0[2], v0[3]); w.z = cvt_pk_bf16(v1[0], v1[1]); w.w = cvt_pk_bf16(v1[2], v1[3]);
                    *(u32x4*)op = w;
                }
            }
    }
};
struct EpiF32 {
    static constexpr bool PERM = true, AFTER_DRAIN = false;
    float* O; int ldc;
    __device__ __forceinline__ void operator()(const f32x4 (&acc)[2][2][4][2], const Unit& u, int wr, int wc, int fr, int fq) const {
        const int row0 = u.pm * BM + wr * 64 + fr, col0 = u.pn * BM + wc * 32 + 8 * fq;
#pragma unroll
        for (int ai = 0; ai < 2; ++ai)
#pragma unroll
            for (int m = 0; m < 4; ++m) {
                float* rp = O + (size_t)(row0 + ai * HALF + m * 16) * ldc + col0;
#pragma unroll
                for (int bj = 0; bj < 2; ++bj) { *(f32x4*)(rp + bj * HALF) = acc[ai][bj][m][0]; *(f32x4*)(rp + bj * HALF + 4) = acc[ai][bj][m][1]; }
            }
    }
};
struct EpiSwiglu {
    static constexpr bool PERM = true, AFTER_DRAIN = false;
    bf16_t* O; int ldc;
    __device__ __forceinline__ void operator()(const f32x4 (&acc)[2][2][4][2], const Unit& u, int wr, int wc, int fr, int fq) const {
        const int row0 = u.pm * BM + wr * 64 + fr, col0 = u.pn * HALF + wc * 32 + 8 * fq;
#pragma unroll
        for (int ai = 0; ai < 2; ++ai)
#pragma unroll
            for (int m = 0; m < 4; ++m) {
                f32x4 v0, v1;
#pragma unroll
                for (int j = 0; j < 4; ++j) { const float g0 = acc[ai][0][m][0][j], g1 = acc[ai][0][m][1][j];
                    v0[j] = g0 * sigmoidf_(g0) * acc[ai][1][m][0][j]; v1[j] = g1 * sigmoidf_(g1) * acc[ai][1][m][1][j]; }
                u32x4 w; w.x = cvt_pk_bf16(v0[0], v0[1]); w.y = cvt_pk_bf16(v0[2], v0[3]); w.z = cvt_pk_bf16(v1[0], v1[1]); w.w = cvt_pk_bf16(v1[2], v1[3]);
                *(u32x4*)(O + (size_t)(row0 + ai * HALF + m * 16) * ldc + col0) = w;
            }
    }
};
template <class Epi, class Sched, bool ALIGN_EPI = false, bool SP2 = false>
__device__ __forceinline__ void gemm_phase(PG8_LAS unsigned char* lds, const Gemm g, const Sched& S, const Epi& E) {
    const int tid = threadIdx.x, wid = __builtin_amdgcn_readfirstlane(tid >> 6), lane = tid & 63, wr = wid >> 2, wc = wid & 3, fr = lane & 15, fq = lane >> 4;
    const int K = g.K, nt = K / BK;
    unsigned voffA[2], voffB[2];
#pragma unroll
    for (int i = 0; i < 2; ++i) { int R, C; stage_rc(tid * 16 + i * 8192, R, C); const int Rb = Epi::PERM ? ((R & ~31) + perm32(R & 31)) : R;
        voffA[i] = (unsigned)(R * K + C) * 2u; voffB[i] = (unsigned)(Rb * K + C) * 2u; }
    const size_t kstep = (size_t)(BK * 2);
    const size_t hstep = (size_t)HALF * K * 2;
    const size_t tstep = 2 * hstep;
    const unsigned ldsw = (unsigned)wid * 1024u;
    const int aoff = lds_byte(wr * 64 + fr, fq * 8), boff = lds_byte(wc * 32 + fr, fq * 8);
#define PG8_SA(b, h) (((b) * 2 + (h)) * HTB)
#define PG8_SB(b, h) ((4 + (b) * 2 + (h)) * HTB)
#define PG8_STAGE(bufoff, gbase, voff) do { _Pragma("unroll") for (int _i = 0; _i < 2; ++_i) \
        __builtin_amdgcn_global_load_lds((const unsigned*)((const char*)(gbase) + (voff)[_i]), (PG8_LAS unsigned*)(lds + (bufoff) + ldsw + _i * 8192), 16, 0, 0); } while (0)
#define PG8_LDA(dst, b, h) do { _Pragma("unroll") for (int m = 0; m < 4; ++m) _Pragma("unroll") for (int k = 0; k < 2; ++k) dst[m][k] = *(const PG8_LAS bf16x8*)(lds + PG8_SA(b, h) + aoff + m * 2048 + k * 1024); } while (0)
#define PG8_LDB(dst, b, h) do { _Pragma("unroll") for (int n = 0; n < 2; ++n) _Pragma("unroll") for (int k = 0; k < 2; ++k) dst[n][k] = *(const PG8_LAS bf16x8*)(lds + PG8_SB(b, h) + boff + n * 2048 + k * 1024); } while (0)
#define PG8_MMA(ai, bj, At, Bt) do { __builtin_amdgcn_s_setprio(1); _Pragma("unroll") for (int m = 0; m < 4; ++m) _Pragma("unroll") for (int n = 0; n < 2; ++n) _Pragma("unroll") for (int k = 0; k < 2; ++k) \
        acc[ai][bj][m][n] = __builtin_amdgcn_mfma_f32_16x16x32_bf16(Bt[n][k], At[m][k], acc[ai][bj][m][n], 0, 0, 0); __builtin_amdgcn_s_setprio(0); } while (0)
#define PG8_WAIT_V(n) asm volatile("s_waitcnt vmcnt(" #n ")" ::: "memory")
#define PG8_WAIT_L(n) asm volatile("s_waitcnt lgkmcnt(" #n ")" ::: "memory")
#define PG8_BAR __builtin_amdgcn_s_barrier()
#define PG8_SCHED __builtin_amdgcn_sched_barrier(0)
    Unit cur, nxt; int ui = 0;
    if (!S.next(0, cur)) return;
    f32x4 acc[2][2][4][2];
#pragma unroll
    for (int a = 0; a < 2; ++a)
#pragma unroll
        for (int b = 0; b < 2; ++b)
#pragma unroll
            for (int m = 0; m < 4; ++m)
#pragma unroll
                for (int n = 0; n < 2; ++n) acc[a][b][m][n] = (f32x4){0.f, 0.f, 0.f, 0.f};
    bf16x8 At[4][2], B0[2][2], B1[2][2];
    const char* cA = (const char*)g.A + (size_t)cur.pm * tstep; const char* cB = (const char*)g.Bt + (size_t)cur.pn * tstep;
    S.a_ready(cur);
    if constexpr (SP2) {
        PG8_STAGE(PG8_SB(0, 0), cB, voffB); PG8_STAGE(PG8_SB(0, 1), cB + hstep, voffB); PG8_STAGE(PG8_SA(0, 0), cA, voffA); PG8_STAGE(PG8_SA(0, 1), cA + hstep, voffA);
        if (wr == 1) PG8_BAR;
        PG8_WAIT_V(2); PG8_BAR;
        PG8_STAGE(PG8_SB(1, 0), cB + kstep, voffB); PG8_STAGE(PG8_SA(1, 0), cA + kstep, voffA); PG8_STAGE(PG8_SB(1, 1), cB + hstep + kstep, voffB);
        PG8_WAIT_V(6); PG8_BAR;
    } else {
        PG8_STAGE(PG8_SB(0, 0), cB, voffB); PG8_STAGE(PG8_SA(0, 0), cA, voffA); PG8_STAGE(PG8_SB(0, 1), cB + hstep, voffB); PG8_STAGE(PG8_SA(0, 1), cA + hstep, voffA);
        if (wr == 1) PG8_BAR;
        PG8_WAIT_V(4); PG8_BAR;
        PG8_STAGE(PG8_SB(1, 0), cB + kstep, voffB); PG8_STAGE(PG8_SA(1, 0), cA + kstep, voffA); PG8_STAGE(PG8_SB(1, 1), cB + hstep + kstep, voffB);
        PG8_WAIT_V(6); PG8_BAR;
    }
    for (;;) {
        const bool has_next = S.next(ui + 1, nxt);
        const char* nA = has_next ? (const char*)g.A + (size_t)nxt.pm * tstep : cA; const char* nB = has_next ? (const char*)g.Bt + (size_t)nxt.pn * tstep : cB;
        for (int t = 0; t < nt; t += 2) {
            const bool last = (t == nt - 2);
            const char* a1 = cA + (size_t)(t + 1) * kstep;
            const char* a2 = last ? nA : cA + (size_t)(t + 2) * kstep; const char* b2 = last ? nB : cB + (size_t)(t + 2) * kstep;
            const char* a3 = a2 + kstep; const char* b3 = b2 + kstep;
            if (last && has_next) S.a_ready(nxt);
            if constexpr (SP2) {
            PG8_LDB(B0, 0, 0); PG8_LDB(B1, 0, 1); PG8_SCHED; PG8_LDA(At, 0, 0); PG8_STAGE(PG8_SA(1, 1), a1 + hstep, voffA);
            PG8_WAIT_V(8); PG8_WAIT_L(0); PG8_BAR; PG8_MMA(0, 0, At, B0); PG8_MMA(0, 1, At, B1); PG8_BAR; PG8_SCHED;
            PG8_LDA(At, 0, 1); PG8_STAGE(PG8_SB(0, 0), b2, voffB); PG8_STAGE(PG8_SB(0, 1), b2 + hstep, voffB); PG8_STAGE(PG8_SA(0, 0), a2, voffA);
            PG8_WAIT_V(8); PG8_WAIT_L(0); PG8_BAR; PG8_MMA(1, 0, At, B0); PG8_MMA(1, 1, At, B1); PG8_BAR; PG8_SCHED;
            PG8_LDB(B0, 1, 0); PG8_LDB(B1, 1, 1); PG8_SCHED; PG8_LDA(At, 1, 0); PG8_STAGE(PG8_SA(0, 1), a2 + hstep, voffA);
            PG8_WAIT_V(8); PG8_WAIT_L(0); PG8_BAR; PG8_MMA(0, 0, At, B0); PG8_MMA(0, 1, At, B1); PG8_BAR; PG8_SCHED;
            PG8_LDA(At, 1, 1); PG8_STAGE(PG8_SB(1, 0), b3, voffB); PG8_STAGE(PG8_SB(1, 1), b3 + hstep, voffB); PG8_STAGE(PG8_SA(1, 0), a3, voffA);
            PG8_WAIT_V(8); PG8_WAIT_L(0); PG8_BAR; PG8_MMA(1, 0, At, B0); PG8_MMA(1, 1, At, B1); PG8_BAR; PG8_SCHED;
            } else {
            PG8_LDB(B0, 0, 0); PG8_SCHED; PG8_LDA(At, 0, 0); PG8_STAGE(PG8_SA(1, 1), a1 + hstep, voffA);
            PG8_WAIT_L(8); PG8_BAR; PG8_WAIT_L(0); PG8_MMA(0, 0, At, B0); PG8_BAR; PG8_SCHED;
            PG8_LDB(B1, 0, 1); PG8_STAGE(PG8_SB(0, 0), b2, voffB);
            PG8_BAR; PG8_WAIT_L(0); PG8_MMA(0, 1, At, B1); PG8_BAR;
            PG8_LDA(At, 0, 1); PG8_STAGE(PG8_SA(0, 0), a2, voffA);
            PG8_BAR; PG8_WAIT_L(0); PG8_MMA(1, 0, At, B0); PG8_BAR; PG8_SCHED;
            PG8_STAGE(PG8_SB(0, 1), b2 + hstep, voffB);
            PG8_WAIT_V(6); PG8_BAR; PG8_MMA(1, 1, At, B1); PG8_BAR;
            PG8_LDB(B0, 1, 0); PG8_SCHED; PG8_LDA(At, 1, 0); PG8_STAGE(PG8_SA(0, 1), a2 + hstep, voffA);
            PG8_WAIT_L(8); PG8_BAR; PG8_WAIT_L(0); PG8_MMA(0, 0, At, B0); PG8_BAR; PG8_SCHED;
            PG8_LDB(B1, 1, 1); PG8_STAGE(PG8_SB(1, 0), b3, voffB);
            PG8_BAR; PG8_WAIT_L(0); PG8_MMA(0, 1, At, B1); PG8_BAR;
            PG8_LDA(At, 1, 1); PG8_STAGE(PG8_SA(1, 0), a3, voffA);
            PG8_BAR; PG8_WAIT_L(0); PG8_MMA(1, 0, At, B0); PG8_BAR; PG8_SCHED;
            PG8_STAGE(PG8_SB(1, 1), b3 + hstep, voffB);
            PG8_WAIT_V(6); PG8_BAR; PG8_MMA(1, 1, At, B1); PG8_BAR;
            }
        }
        if constexpr (ALIGN_EPI) { if (wr == 0) PG8_BAR; }
        if constexpr (!Epi::AFTER_DRAIN) { E(acc, cur, wr, wc, fr, fq); S.done(cur); }
        if (!has_next) break;
#pragma unroll
        for (int a = 0; a < 2; ++a)
#pragma unroll
            for (int b = 0; b < 2; ++b)
#pragma unroll
                for (int m = 0; m < 4; ++m)
#pragma unroll
                    for (int n = 0; n < 2; ++n) acc[a][b][m][n] = (f32x4){0.f, 0.f, 0.f, 0.f};
        cur = nxt; cA = nA; cB = nB; ++ui;
        if constexpr (ALIGN_EPI) { if (wr == 1) PG8_BAR; }
    }
    PG8_WAIT_V(0);
    if constexpr (!ALIGN_EPI) { if (wr == 0) PG8_BAR; }
    PG8_BAR;
    if constexpr (Epi::AFTER_DRAIN) { E.fused(acc, cur, wr, wc, fr, fq, lds, wid, lane); S.done(cur); }
#undef PG8_SA
#undef PG8_SB
#undef PG8_STAGE
#undef PG8_LDA
#undef PG8_LDB
#undef PG8_MMA
#undef PG8_WAIT_V
#undef PG8_WAIT_L
#undef PG8_BAR
#undef PG8_SCHED
}
}

namespace att {
#define ALAS __attribute__((address_space(3)))
typedef unsigned short bf16;
typedef short bf16x8 __attribute__((ext_vector_type(8)));
typedef short s16x4 __attribute__((ext_vector_type(4)));
typedef float f32x16 __attribute__((ext_vector_type(16)));
typedef float f32x4 __attribute__((ext_vector_type(4)));
typedef float f32x2 __attribute__((ext_vector_type(2)));
typedef __bf16 bf16x2_t __attribute__((ext_vector_type(2)));
typedef unsigned u32x4 __attribute__((ext_vector_type(4)));
typedef unsigned u32x2 __attribute__((ext_vector_type(2)));
constexpr int PITCH = 4352, OPITCH = 512, BUFB = 16640;
__device__ __forceinline__ unsigned cvtpk(float lo, float hi) { f32x2 v = {lo, hi}; bf16x2_t b = __builtin_convertvector(v, bf16x2_t); return __builtin_bit_cast(unsigned, b); }
__device__ __forceinline__ s16x4 vtr(const ALAS unsigned char* p) { return __builtin_bit_cast(s16x4, __builtin_amdgcn_ds_read_tr16_b64_v4i16((ALAS s16x4*)p)); }
__device__ __forceinline__ int crow(int i, int h) { return (i & 3) + 8 * (i >> 2) + 4 * h; }

template <int MODE>
__device__ __forceinline__ void attn_unit(ALAS unsigned char* shm, const bf16* Qp, const bf16* Kp, const bf16* Vp, bf16* Op, const float* biasp, float m_init, int q0, int t_lo, int t_hi) {
    const int tid = threadIdx.x, lane = tid & 63, r = lane & 31, h = lane >> 5;
    const int wid = __builtin_amdgcn_readfirstlane(tid >> 6);
    const int qw0 = q0 + wid * 32, qrow = qw0 + r;
    const bf16* ksrc = Kp + (size_t)lane * PITCH + wid * 8;
    const bf16* vsrc = Vp + (size_t)(16 * (wid & 3) + (lane >> 2)) * PITCH + (wid >> 2) * 32 + (lane & 3) * 8;
    const int sdst = wid * 1024 + lane * 16;
    bf16x8 qr[4];
#pragma unroll
    for (int d0 = 0; d0 < 4; ++d0) qr[d0] = *(const bf16x8*)(Qp + (size_t)qrow * PITCH + d0 * 16 + h * 8);
    f32x16 o0, o1;
#pragma unroll
    for (int i = 0; i < 16; ++i) { o0[i] = 0.f; o1[i] = 0.f; }
    float m = m_init, l = (MODE == 1 && h == 0) ? 1.0f : 0.0f;
    u32x4 kreg, vreg; float breg = 0.f;
    kreg = *(const u32x4*)(ksrc + (size_t)t_lo * 64 * PITCH); vreg = *(const u32x4*)(vsrc + (size_t)t_lo * 64 * PITCH);
    if (MODE == 0 && tid < 64) breg = biasp[t_lo * 64 + tid];
    *(ALAS u32x4*)(shm + sdst) = kreg; *(ALAS u32x4*)(shm + 8192 + sdst) = vreg;
    if (MODE == 0 && tid < 64) *(ALAS float*)(shm + 16384 + tid * 4) = breg;
    __syncthreads();
    const int nt = t_hi - t_lo;
    for (int it = 0; it < nt; ++it) {
        const int t = t_lo + it;
        ALAS unsigned char* buf = shm + (it & 1) * BUFB;
        const bool more = it + 1 < nt;
        if (more) { kreg = *(const u32x4*)(ksrc + (size_t)(t + 1) * 64 * PITCH); vreg = *(const u32x4*)(vsrc + (size_t)(t + 1) * 64 * PITCH);
                    if (MODE == 0 && tid < 64) breg = biasp[(t + 1) * 64 + tid]; }
        const int k0 = t * 64;
        const bool need = (k0 <= qw0 + 31) && (MODE == 0 || (k0 + 63 >= qw0 - 127));
        if (need) {
            f32x16 s0, s1;
#pragma unroll
            for (int i = 0; i < 16; ++i) { s0[i] = 0.f; s1[i] = 0.f; }
#pragma unroll
            for (int d0 = 0; d0 < 4; ++d0) {
                const bf16x8 ka = *(const ALAS bf16x8*)(buf + (2 * d0 + h) * 1024 + r * 16);
                const bf16x8 kb = *(const ALAS bf16x8*)(buf + (2 * d0 + h) * 1024 + (32 + r) * 16);
                s0 = __builtin_amdgcn_mfma_f32_32x32x16_bf16(ka, qr[d0], s0, 0, 0, 0);
                s1 = __builtin_amdgcn_mfma_f32_32x32x16_bf16(kb, qr[d0], s1, 0, 0, 0);
            }
            if (MODE == 0) {
#pragma unroll
                for (int g = 0; g < 4; ++g) {
                    const f32x4 b0 = *(const ALAS f32x4*)(buf + 16384 + (8 * g + 4 * h) * 4), b1 = *(const ALAS f32x4*)(buf + 16384 + (32 + 8 * g + 4 * h) * 4);
#pragma unroll
                    for (int j = 0; j < 4; ++j) { s0[4 * g + j] += b0[j]; s1[4 * g + j] += b1[j]; }
                }
            }
            const bool boundary = (MODE == 1) || (k0 + 63 > qw0);
            if (boundary) {
#pragma unroll
                for (int i = 0; i < 16; ++i) {
                    const int ka0 = k0 + crow(i, h), ka1 = ka0 + 32;
                    const bool v0 = (ka0 <= qrow) && (MODE == 0 || (qrow - ka0 < 128));
                    const bool v1 = (ka1 <= qrow) && (MODE == 0 || (qrow - ka1 < 128));
                    s0[i] = v0 ? s0[i] : -INFINITY; s1[i] = v1 ? s1[i] : -INFINITY;
                }
            }
            float mx = fmaxf(s0[0], s1[0]);
#pragma unroll
            for (int i = 1; i < 16; ++i) mx = fmaxf(mx, fmaxf(s0[i], s1[i]));
            mx = fmaxf(mx, __shfl_xor(mx, 32));
            const float mn = fmaxf(m, mx);
            const float alpha = __builtin_amdgcn_exp2f(m - mn);
            m = mn;
            float ps = 0.f;
#pragma unroll
            for (int i = 0; i < 16; ++i) { s0[i] = __builtin_amdgcn_exp2f(s0[i] - mn); s1[i] = __builtin_amdgcn_exp2f(s1[i] - mn); ps += s0[i] + s1[i]; }
            l = l * alpha + ps;
#pragma unroll
            for (int i = 0; i < 16; ++i) { o0[i] *= alpha; o1[i] *= alpha; }
            const ALAS unsigned char* vb = buf + 8192 + (4 * h + ((lane & 15) >> 2)) * 64 + ((lane >> 4) & 1) * 32 + (lane & 3) * 8;
#pragma unroll
            for (int sb = 0; sb < 2; ++sb)
#pragma unroll
                for (int ks = 0; ks < 2; ++ks) {
                    u32x4 pw;
                    if (sb == 0) { pw.x = cvtpk(s0[8 * ks + 0], s0[8 * ks + 1]); pw.y = cvtpk(s0[8 * ks + 2], s0[8 * ks + 3]); pw.z = cvtpk(s0[8 * ks + 4], s0[8 * ks + 5]); pw.w = cvtpk(s0[8 * ks + 6], s0[8 * ks + 7]); }
                    else         { pw.x = cvtpk(s1[8 * ks + 0], s1[8 * ks + 1]); pw.y = cvtpk(s1[8 * ks + 2], s1[8 * ks + 3]); pw.z = cvtpk(s1[8 * ks + 4], s1[8 * ks + 5]); pw.w = cvtpk(s1[8 * ks + 6], s1[8 * ks + 7]); }
                    const bf16x8 pf = __builtin_bit_cast(bf16x8, pw);
                    const ALAS unsigned char* vp = vb + (32 * sb + 16 * ks) * 64;
                    const s16x4 a0 = vtr(vp), a1 = vtr(vp + 512), c0 = vtr(vp + 4096), c1 = vtr(vp + 4096 + 512);
                    const bf16x8 vf0 = {a0[0], a0[1], a0[2], a0[3], a1[0], a1[1], a1[2], a1[3]};
                    const bf16x8 vf1 = {c0[0], c0[1], c0[2], c0[3], c1[0], c1[1], c1[2], c1[3]};
                    o0 = __builtin_amdgcn_mfma_f32_32x32x16_bf16(vf0, pf, o0, 0, 0, 0);
                    o1 = __builtin_amdgcn_mfma_f32_32x32x16_bf16(vf1, pf, o1, 0, 0, 0);
                }
        }
        if (more) {
            ALAS unsigned char* nb = shm + ((it + 1) & 1) * BUFB;
            *(ALAS u32x4*)(nb + sdst) = kreg; *(ALAS u32x4*)(nb + 8192 + sdst) = vreg;
            if (MODE == 0 && tid < 64) *(ALAS float*)(nb + 16384 + tid * 4) = breg;
        }
        __syncthreads();
    }
    const float lt = l + __shfl_xor(l, 32);
    const float inv = 1.0f / lt;
    bf16* orow = Op + (size_t)qrow * OPITCH;
#pragma unroll
    for (int g = 0; g < 4; ++g) {
        u32x2 w0, w1;
        w0.x = cvtpk(o0[4 * g + 0] * inv, o0[4 * g + 1] * inv); w0.y = cvtpk(o0[4 * g + 2] * inv, o0[4 * g + 3] * inv);
        w1.x = cvtpk(o1[4 * g + 0] * inv, o1[4 * g + 1] * inv); w1.y = cvtpk(o1[4 * g + 2] * inv, o1[4 * g + 3] * inv);
        *(u32x2*)(orow + 8 * g + 4 * h) = w0; *(u32x2*)(orow + 32 + 8 * g + 4 * h) = w1;
    }
}
}
#define GAS __attribute__((address_space(1)))
#define LAS __attribute__((address_space(3)))
typedef unsigned short bf16;
typedef unsigned v4u __attribute__((ext_vector_type(4)));
typedef float f32x4 __attribute__((ext_vector_type(4)));
constexpr int NWAVES = 8, NTHR = NWAVES * 64;
constexpr int BATCH = 8, SEQ = 4096, D = 1024, M = BATCH * SEQ, DFF = 2816, INW = 4360, PROJW = 4352, NADA = 6;
constexpr float RMS_EPS = 1e-6f, LOG2E = 1.4426950408889634f;
constexpr size_t MiB = 1u << 20;
constexpr size_t WS_ADA = 1 * MiB;
constexpr size_t WS_WF = WS_ADA + 256 * 1024;
constexpr size_t WS_LOGF = 2 * MiB;
constexpr size_t WS_CUM = 3 * MiB;
constexpr size_t WS_COS = 4 * MiB, WS_SIN = 8 * MiB;
constexpr size_t WS_WIN = 12 * MiB;
constexpr size_t WS_WA = 21 * MiB, WS_WB = 22 * MiB;
constexpr size_t WS_WOUT = 23 * MiB;
constexpr size_t WS_WFI = 25 * MiB;
constexpr size_t WS_WFO = 36 * MiB;
constexpr size_t WS_H = 48 * MiB;
constexpr size_t WS_MERGED = 112 * MiB;
constexpr size_t WS_PROJ = 176 * MiB;
constexpr size_t WS_END = 448 * MiB;
constexpr int LDS_BYTES = 147456;

__device__ __forceinline__ unsigned f2bf(float f) { unsigned u = __builtin_bit_cast(unsigned, f); return (u + 0x7fffu + ((u >> 16) & 1u)) >> 16; }
__device__ __forceinline__ unsigned pk2(float lo, float hi) { return f2bf(lo) | (f2bf(hi) << 16); }
__device__ __forceinline__ float wave_sum(float v) {
#pragma unroll
    for (int o = 1; o < 64; o <<= 1) v += __shfl_xor(v, o);
    return v;
}
template <class CM>
__device__ __forceinline__ void transpose_item(const float* W, int K, int ldw, int Nst, bf16* WT, LAS float* scr, int item, int lane, CM cm) {
    const int nblk = Nst / 32, kb = item / nblk, nb = item % nblk, k0 = 64 * kb, n0 = 32 * nb;
    const int sc = cm(n0 + (lane & 31));
#pragma unroll 8
    for (int i = 0; i < 32; ++i) { const int kk = 2 * i + (lane >> 5); scr[kk * 33 + (lane & 31)] = W[(size_t)(k0 + kk) * ldw + sc]; }
    asm volatile("s_waitcnt lgkmcnt(0)" ::: "memory");
    const int c = lane & 7;
#pragma unroll
    for (int j = 0; j < 4; ++j) { const int n = (lane >> 3) + 8 * j; const LAS float* s = scr + (8 * c) * 33 + n;
        v4u o; o.x = pk2(s[0 * 33], s[1 * 33]); o.y = pk2(s[2 * 33], s[3 * 33]); o.z = pk2(s[4 * 33], s[5 * 33]); o.w = pk2(s[6 * 33], s[7 * 33]);
        *(v4u*)(WT + (size_t)(n0 + n) * K + k0 + 8 * c) = o; }
    asm volatile("s_waitcnt lgkmcnt(0)" ::: "memory");
}
struct CmId { __device__ __forceinline__ int operator()(int n) const { return n; } };
struct CmWin { __device__ __forceinline__ int operator()(int n) const {
    if (n < 640) { const int p = n & 63, g = p >> 3, e = p & 7; return (n & ~63) + ((e < 4) ? (4 * g + e) : (32 + 4 * g + (e - 4))); }
    return n < 2304 ? n : n + 8; } };
struct CmFfn { __device__ __forceinline__ int operator()(int n) const { const int t = n >> 8, w = n & 255; return (w < 128) ? (128 * t + w) : (DFF + 128 * t + (w - 128)); } };

struct Args { const void* in[17]; float* out; unsigned char* ws; };

__device__ __forceinline__ float log_sigmoid_(float z) { return z >= 0.f ? -log1pf(__expf(-z)) : z - log1pf(__expf(z)); }

__global__ void __launch_bounds__(NTHR, 2) mega_fwd(Args args) {
    extern __shared__ __attribute__((aligned(16))) unsigned char lds_raw[];
    LAS unsigned char* lds = (LAS unsigned char*)lds_raw;
    cg::grid_group grid = cg::this_grid();
    const int tid = threadIdx.x, lane = tid & 63, wave = __builtin_amdgcn_readfirstlane(tid >> 6);
    const int G = gridDim.x, bx = blockIdx.x;
    const int vcu = (G % 8 == 0) ? (bx % 8) * (G / 8) + bx / 8 : bx;
    const int gw = vcu * NWAVES + wave, NGW = G * NWAVES;
    unsigned char* ws = args.ws;
    const float* x = (const float*)args.in[0]; const float* cvec = (const float*)args.in[1]; const int* positions = (const int*)args.in[2];
    const float* w_ada = (const float*)args.in[3]; const float* b_ada = (const float*)args.in[4];
    const float* g_pre_mix = (const float*)args.in[5]; const float* g_post_mix = (const float*)args.in[6];
    const float* w_in = (const float*)args.in[7]; const float* b_f = (const float*)args.in[8]; const float* sinks = (const float*)args.in[9];
    const float* w_branch_a = (const float*)args.in[10]; const float* w_branch_b = (const float*)args.in[11]; const float* w_out = (const float*)args.in[12];
    const float* g_pre_ffn = (const float*)args.in[13]; const float* g_post_ffn = (const float*)args.in[14];
    const float* w_ffn_in = (const float*)args.in[15]; const float* w_ffn_out = (const float*)args.in[16];
    float* out = args.out;
    float* ADA = (float*)(ws + WS_ADA); float* WF = (float*)(ws + WS_WF); float* LOGF = (float*)(ws + WS_LOGF); float* CUM = (float*)(ws + WS_CUM);
    float* COS = (float*)(ws + WS_COS); float* SIN = (float*)(ws + WS_SIN);
    bf16* WIN = (bf16*)(ws + WS_WIN); bf16* WA = (bf16*)(ws + WS_WA); bf16* WB = (bf16*)(ws + WS_WB); bf16* WOUT = (bf16*)(ws + WS_WOUT);
    bf16* WFI = (bf16*)(ws + WS_WFI); bf16* WFO = (bf16*)(ws + WS_WFO);
    bf16* H = (bf16*)(ws + WS_H); bf16* OA = (bf16*)(ws + WS_H); bf16* OB = OA + (size_t)M * 512; bf16* H2 = (bf16*)(ws + WS_H); float* Y2 = (float*)(ws + WS_H);
    bf16* MERGED = (bf16*)(ws + WS_MERGED);
    bf16* PROJ = (bf16*)(ws + WS_PROJ); float* Y = (float*)(ws + WS_PROJ); bf16* ACT = (bf16*)(ws + WS_PROJ);

    {
        LAS float* cl = (LAS float*)lds;
        LAS float* part = (LAS float*)(lds + 32768);
        for (int i = tid; i < 8 * 1024; i += NTHR) { const int b = i >> 10, k = i & 1023; cl[k * 8 + b] = cvec[i]; }
        __syncthreads();
        for (int ch = vcu; ch < 256; ch += G) {
            const int n0 = 24 * ch;
            if (tid < 504) {
                const int col = tid % 24, kg = tid / 24;
                float a[8];
#pragma unroll
                for (int b = 0; b < 8; ++b) a[b] = 0.f;
                for (int k = kg; k < 1024; k += 21) {
                    const float w = w_ada[(size_t)k * (NADA * D) + n0 + col];
                    const f32x4 c0 = *(const LAS f32x4*)(cl + k * 8), c1 = *(const LAS f32x4*)(cl + k * 8 + 4);
                    a[0] += w * c0[0]; a[1] += w * c0[1]; a[2] += w * c0[2]; a[3] += w * c0[3];
                    a[4] += w * c1[0]; a[5] += w * c1[1]; a[6] += w * c1[2]; a[7] += w * c1[3];
                }
#pragma unroll
                for (int b = 0; b < 8; ++b) part[(kg * 24 + col) * 8 + b] = a[b];
            }
            __syncthreads();
            if (tid < 192) {
                const int col = tid >> 3, b = tid & 7; float s = b_ada[n0 + col];
                for (int kg = 0; kg < 21; ++kg) s += part[(kg * 24 + col) * 8 + b];
                ADA[b * (NADA * D) + n0 + col] = s;
            }
            __syncthreads();
        }
        LAS float* scr = (LAS float*)(lds + wave * 16384);
        constexpr int I_IN = (D / 64) * (PROJW / 32), I_A = (512 / 64) * (D / 32), I_O = (D / 64) * (D / 32), I_FI = (D / 64) * (2 * DFF / 32), I_FO = (DFF / 64) * (D / 32);
        constexpr int NITEMS = I_IN + 2 * I_A + I_O + I_FI + I_FO;
        for (int it = gw; it < NITEMS; it += NGW) {
            int r = it;
            if (r < I_IN) { transpose_item(w_in, D, INW, PROJW, WIN, scr, r, lane, CmWin()); continue; } r -= I_IN;
            if (r < I_A) { transpose_item(w_branch_a, 512, D, D, WA, scr, r, lane, CmId()); continue; } r -= I_A;
            if (r < I_A) { transpose_item(w_branch_b, 512, D, D, WB, scr, r, lane, CmId()); continue; } r -= I_A;
            if (r < I_O) { transpose_item(w_out, D, D, D, WOUT, scr, r, lane, CmId()); continue; } r -= I_O;
            if (r < I_FI) { transpose_item(w_ffn_in, D, 2 * DFF, 2 * DFF, WFI, scr, r, lane, CmFfn()); continue; } r -= I_FI;
            transpose_item(w_ffn_out, DFF, D, D, WFO, scr, r, lane, CmId());
        }
        for (int i = vcu * NTHR + tid; i < 8 * 1024; i += G * NTHR) { const int j = i >> 10, k = i & 1023; WF[i] = w_in[(size_t)k * INW + 2304 + j]; }
        for (int i = vcu * NTHR + tid; i < M * 32; i += G * NTHR) {
            const int row = i >> 5, f = i & 31;
            const double inv_freq = exp(-(double)f * (9.210340371976184 / 32.0));
            const double ang = (double)positions[row] * inv_freq;
            const double qd = rint(ang * 0.6366197723675814);
            const double rr = fma(-qd, 1.5707963267948966, ang) - qd * 6.123233995736766e-17;
            const double r2 = rr * rr;
            const double sp = rr * (1.0 + r2 * (-1.0 / 6 + r2 * (1.0 / 120 + r2 * (-1.0 / 5040 + r2 * (1.0 / 362880 + r2 * (-1.0 / 39916800 + r2 * (1.0 / 6227020800.0)))))));
            const double cp = 1.0 + r2 * (-0.5 + r2 * (1.0 / 24 + r2 * (-1.0 / 720 + r2 * (1.0 / 40320 + r2 * (-1.0 / 3628800 + r2 * (1.0 / 479001600.0 + r2 * (-1.0 / 87178291200.0)))))));
            const int qi = ((int)qd) & 3;
            const double sv = (qi == 0) ? sp : (qi == 1) ? cp : (qi == 2) ? -sp : -cp;
            const double cv = (qi == 0) ? cp : (qi == 1) ? -sp : (qi == 2) ? -cp : sp;
            COS[i] = (float)cv; SIN[i] = (float)sv;
        }
    }
    grid.sync();

    {
        LAS float* wf = (LAS float*)lds;
        for (int i = tid; i < 8 * 1024; i += NTHR) wf[i] = WF[i];
        __syncthreads();
        for (int row = gw; row < M; row += NGW) {
            const int b = row / SEQ;
            const f32x4* xr = (const f32x4*)(x + (size_t)row * D) + lane;
            const float* ada = ADA + b * (NADA * D);
            f32x4 v[4]; float ss = 0.f;
#pragma unroll
            for (int j = 0; j < 4; ++j) { v[j] = xr[64 * j]; ss += (v[j][0] * v[j][0] + v[j][1] * v[j][1]) + (v[j][2] * v[j][2] + v[j][3] * v[j][3]); }
            const float rstd = 1.0f / sqrtf(wave_sum(ss) * (1.0f / D) + RMS_EPS);
            float fl[8];
#pragma unroll
            for (int jj = 0; jj < 8; ++jj) fl[jj] = 0.f;
            unsigned long long* o8 = (unsigned long long*)(H + (size_t)row * D) + lane;
#pragma unroll
            for (int j = 0; j < 4; ++j) {
                const int cidx = 4 * (lane + 64 * j);
                const f32x4 g = *(const f32x4*)(g_pre_mix + cidx), sc = *(const f32x4*)(ada + 1 * D + cidx), sh = *(const f32x4*)(ada + 0 * D + cidx);
                const f32x4 hv = v[j] * rstd * g * (sc + 1.0f) + sh;
#pragma unroll
                for (int jj = 0; jj < 8; ++jj) { const f32x4 w = *(const LAS f32x4*)(wf + jj * 1024 + cidx); fl[jj] += (hv[0] * w[0] + hv[1] * w[1]) + (hv[2] * w[2] + hv[3] * w[3]); }
                o8[64 * j] = (unsigned long long)pk2(hv[0], hv[1]) | ((unsigned long long)pk2(hv[2], hv[3]) << 32);
            }
            float mine = 0.f;
#pragma unroll
            for (int jj = 0; jj < 8; ++jj) { const float s = wave_sum(fl[jj]); if (lane == jj) mine = s; }
            if (lane < 8) LOGF[(size_t)row * 8 + lane] = log_sigmoid_(mine + b_f[lane]);
        }
    }
    grid.sync();

    {
        LAS float* wt = (LAS float*)lds;
        for (int bh = bx; bh < BATCH * 8; bh += G) {
            const int b = bh >> 3, hh = bh & 7;
            float vals[8]; float run = 0.f;
#pragma unroll
            for (int e = 0; e < 8; ++e) { run += LOGF[((size_t)b * SEQ + tid * 8 + e) * 8 + hh]; vals[e] = run; }
            float inc = run;
#pragma unroll
            for (int o = 1; o < 64; o <<= 1) { const float nb = __shfl_up(inc, o); if (lane >= o) inc += nb; }
            if (lane == 63) wt[wave] = inc;
            __syncthreads();
            float base = inc - run;
            for (int w = 0; w < wave; ++w) base += wt[w];
#pragma unroll
            for (int e = 0; e < 8; ++e) CUM[(size_t)bh * SEQ + tid * 8 + e] = -(base + vals[e]) * LOG2E;
            __syncthreads();
        }
        pg8::Gemm g{H, WIN, M, PROJW, D}; pg8::StaticOrder S; S.init(M, PROJW, G, bx);
        pg8::EpiProj E{PROJ, COS, SIN};
        pg8::gemm_phase<pg8::EpiProj, pg8::StaticOrder, true, true>(lds, g, S, E);
    }
    grid.sync();

    {
        for (int j = vcu; j < 256; j += G) {
            const int bh = j >> 2, s = j & 3, b = bh >> 3, hh = bh & 7;
            const bf16* base = PROJ + (size_t)b * SEQ * PROJW;
#pragma unroll 1
            for (int k = 0; k < 4; ++k) {
                const int qb = (k == 0) ? 15 - s : (k == 1) ? 8 + s : (k == 2) ? 7 - s : s;
                att::attn_unit<0>(lds, base + 768 + hh * 64, base + 1280 + hh * 64, base + 1792 + hh * 64, OB + (size_t)b * SEQ * 512 + hh * 64,
                                  CUM + (size_t)bh * SEQ, -1e30f, qb * 256, 0, 4 * qb + 4);
            }
        }
        for (int j = vcu; j < 256; j += G) {
#pragma unroll 1
            for (int k = 0; k < 4; ++k) {
                const int u = 4 * j + k, qb = u & 15, qh = (u >> 4) & 7, b = u >> 7;
                const bf16* base = PROJ + (size_t)b * SEQ * PROJW;
                const int tlo = (4 * qb - 2) > 0 ? (4 * qb - 2) : 0;
                att::attn_unit<1>(lds, base + qh * 64, base + 512 + (qh >> 2) * 64, base + 640 + (qh >> 2) * 64, OA + (size_t)b * SEQ * 512 + qh * 64,
                                  nullptr, sinks[qh] * LOG2E, qb * 256, tlo, 4 * qb + 4);
            }
        }
    }
    grid.sync();

    {
        { pg8::Gemm g{OA, WA, M, D, 512}; pg8::StaticOrder S; S.init(M, D, G, bx); pg8::EpiBranch<false> E{MERGED, PROJ + 2304};
          pg8::gemm_phase<pg8::EpiBranch<false>, pg8::StaticOrder, true, true>(lds, g, S, E); }
        { pg8::Gemm g{OB, WB, M, D, 512}; pg8::StaticOrder S; S.init(M, D, G, bx); pg8::EpiBranch<true> E{MERGED, PROJ + 2304 + 1024};
          pg8::gemm_phase<pg8::EpiBranch<true>, pg8::StaticOrder, true, true>(lds, g, S, E); }
    }
    grid.sync();

    {
        pg8::Gemm g{MERGED, WOUT, M, D, D}; pg8::StaticOrder S; S.init(M, D, G, bx); pg8::EpiF32 E{Y, D};
        pg8::gemm_phase<pg8::EpiF32, pg8::StaticOrder, true, true>(lds, g, S, E);
    }
    grid.sync();

    for (int row = gw; row < M; row += NGW) {
        const int b = row / SEQ;
        const float* ada = ADA + b * (NADA * D);
        const f32x4* yr = (const f32x4*)(Y + (size_t)row * D) + lane;
        const f32x4* xr = (const f32x4*)(x + (size_t)row * D) + lane;
        f32x4* orow = (f32x4*)(out + (size_t)row * D) + lane;
        f32x4 v[4]; float ss = 0.f;
#pragma unroll
        for (int j = 0; j < 4; ++j) { v[j] = yr[64 * j]; ss += (v[j][0] * v[j][0] + v[j][1] * v[j][1]) + (v[j][2] * v[j][2] + v[j][3] * v[j][3]); }
        const float rstd = 1.0f / sqrtf(wave_sum(ss) * (1.0f / D) + RMS_EPS);
        float s2 = 0.f;
#pragma unroll
        for (int j = 0; j < 4; ++j) {
            const int cidx = 4 * (lane + 64 * j);
            const f32x4 g = *(const f32x4*)(g_post_mix + cidx), gt = *(const f32x4*)(ada + 2 * D + cidx);
            v[j] = xr[64 * j] + gt * (v[j] * rstd * g);
            orow[64 * j] = v[j];
            s2 += (v[j][0] * v[j][0] + v[j][1] * v[j][1]) + (v[j][2] * v[j][2] + v[j][3] * v[j][3]);
        }
        const float rstd2 = 1.0f / sqrtf(wave_sum(s2) * (1.0f / D) + RMS_EPS);
        unsigned long long* o8 = (unsigned long long*)(H2 + (size_t)row * D) + lane;
#pragma unroll
        for (int j = 0; j < 4; ++j) {
            const int cidx = 4 * (lane + 64 * j);
            const f32x4 g = *(const f32x4*)(g_pre_ffn + cidx), sc = *(const f32x4*)(ada + 4 * D + cidx), sh = *(const f32x4*)(ada + 3 * D + cidx);
            const f32x4 hv = v[j] * rstd2 * g * (sc + 1.0f) + sh;
            o8[64 * j] = (unsigned long long)pk2(hv[0], hv[1]) | ((unsigned long long)pk2(hv[2], hv[3]) << 32);
        }
    }
    grid.sync();

    {
        pg8::Gemm g{H2, WFI, M, 2 * DFF, D}; pg8::StaticOrder S; S.init(M, 2 * DFF, G, bx); pg8::EpiSwiglu E{ACT, DFF};
        pg8::gemm_phase<pg8::EpiSwiglu, pg8::StaticOrder, true, true>(lds, g, S, E);
    }
    grid.sync();

    {
        pg8::Gemm g{ACT, WFO, M, D, DFF}; pg8::StaticOrder S; S.init(M, D, G, bx); pg8::EpiF32 E{Y2, D};
        pg8::gemm_phase<pg8::EpiF32, pg8::StaticOrder, true, true>(lds, g, S, E);
    }
    grid.sync();

    for (int row = gw; row < M; row += NGW) {
        const int b = row / SEQ;
        const float* ada = ADA + b * (NADA * D);
        const f32x4* yr = (const f32x4*)(Y2 + (size_t)row * D) + lane;
        f32x4* orow = (f32x4*)(out + (size_t)row * D) + lane;
        f32x4 v[4]; float ss = 0.f;
#pragma unroll
        for (int j = 0; j < 4; ++j) { v[j] = yr[64 * j]; ss += (v[j][0] * v[j][0] + v[j][1] * v[j][1]) + (v[j][2] * v[j][2] + v[j][3] * v[j][3]); }
        const float rstd = 1.0f / sqrtf(wave_sum(ss) * (1.0f / D) + RMS_EPS);
#pragma unroll
        for (int j = 0; j < 4; ++j) {
            const int cidx = 4 * (lane + 64 * j);
            const f32x4 g = *(const f32x4*)(g_post_ffn + cidx), gt = *(const f32x4*)(ada + 5 * D + cidx);
            orow[64 * j] = orow[64 * j] + gt * (v[j] * rstd * g);
        }
    }
}

extern "C" void kernel_launch(void* const* d_in, const int* in_sizes, int n_in, void* d_out, int out_size, void* d_ws, size_t ws_size, hipStream_t stream) {
    static int grid = 0;
    if (grid == 0) {
        if (n_in != 17 || in_sizes[0] != M * D || out_size != M * D || ws_size < WS_END) { fprintf(stderr, "kernel_launch: unexpected shapes (n_in %d, in0 %d, out %d, ws %zu)\n", n_in, n_in > 0 ? in_sizes[0] : -1, out_size, ws_size); grid = -1; return; }
        int dev = 0, cus = 0, per_cu = 0;
        if (hipGetDevice(&dev) != hipSuccess || hipDeviceGetAttribute(&cus, hipDeviceAttributeMultiprocessorCount, dev) != hipSuccess) { grid = -1; return; }
        if (hipFuncSetAttribute((const void*)mega_fwd, hipFuncAttributeMaxDynamicSharedMemorySize, LDS_BYTES) != hipSuccess) { fprintf(stderr, "kernel_launch: hipFuncSetAttribute failed\n"); grid = -1; return; }
        if (hipOccupancyMaxActiveBlocksPerMultiprocessor(&per_cu, (const void*)mega_fwd, NTHR, LDS_BYTES) != hipSuccess || per_cu < 1) { fprintf(stderr, "kernel_launch: occupancy query says %d\n", per_cu); per_cu = 1; }
        (void)hipGetLastError();
        grid = cus * 1;
    }
    if (grid < 0) return;
    Args a{};
    for (int i = 0; i < 17; ++i) a.in[i] = d_in[i];
    a.out = (float*)d_out; a.ws = (unsigned char*)d_ws;
    void* kargs[] = {&a};
    hipError_t e = hipLaunchCooperativeKernel((const void*)mega_fwd, dim3(grid), dim3(NTHR), kargs, LDS_BYTES, stream);
    if (e != hipSuccess) fprintf(stderr, "kernel_launch: cooperative launch failed: %s (grid %d)\n", hipGetErrorString(e), grid);
}
```

```cpp
#include <hip/hip_runtime.h>
#include <hip/hip_cooperative_groups.h>
#include <cstdio>
#include <cstdint>
#include <cmath>
namespace cg = cooperative_groups;
namespace pg8 {
#define PG8_LAS __attribute__((address_space(3)))
typedef unsigned short bf16_t;
typedef short bf16x8 __attribute__((ext_vector_type(8)));
typedef float f32x4 __attribute__((ext_vector_type(4)));
typedef unsigned u32x4 __attribute__((ext_vector_type(4)));
constexpr int BM = 256, BK = 64, HALF = 128, HTB = HALF * BK * 2  , STAGE_BYTES = 8 * HTB, NXCD = 8, WGM = 8;

__host__ __device__ __forceinline__ int lds_byte(int r, int c) { const int st = (r >> 4) * 2 + (c >> 5), rr = r & 15, cc = c & 31, ob = rr * 64 + cc * 2; return st * 1024 + (ob ^ (((ob >> 9) & 1) << 5)); }
__host__ __device__ __forceinline__ void stage_rc(int b, int& R, int& C) { const int st = b / 1024, sb = b % 1024, swz = sb ^ (((sb >> 9) & 1) << 5); R = (st >> 1) * 16 + swz / 64; C = (st & 1) * 32 + (swz % 64) / 2; }
__host__ __device__ __forceinline__ int perm32(int rho) { const int n = rho >> 4, i = rho & 15; return 8 * (i >> 2) + 4 * n + (i & 3); }

struct Unit { int pm, pn; };
struct Gemm { const bf16_t* A; const bf16_t* Bt; int M, N, K; };

struct StaticOrder {
    int nM, nN, nwg, G, c;
    __host__ __device__ void init(int M, int N, int G_, int c_) { nM = M / BM; nN = N / BM; nwg = nM * nN; G = G_; c = c_; }
    __host__ __device__ bool next(int i, Unit& u) const {
        const long L = (long)i * G + c; if (L >= nwg) return false;
        int wgid = (int)L; { const int q = nwg / NXCD, r = nwg % NXCD, xcd = wgid % NXCD, off = wgid / NXCD; wgid = (xcd < r ? xcd * (q + 1) : r * (q + 1) + (xcd - r) * q) + off; }
        const int nig = WGM * nN, gid = wgid / nig, fm = gid * WGM, gsz = (nM - fm) < WGM ? (nM - fm) : WGM;
        u.pm = fm + ((wgid % nig) % gsz); u.pn = (wgid % nig) / gsz; return true;
    }
    __device__ __forceinline__ void a_ready(const Unit&) const {}
    __device__ __forceinline__ void done(const Unit&) const {}
};
__device__ __forceinline__ unsigned cvt_pk_bf16(float lo, float hi) { unsigned r; asm volatile("v_cvt_pk_bf16_f32 %0, %1, %2" : "=v"(r) : "v"(lo), "v"(hi)); return r; }
typedef float f32x2 __attribute__((ext_vector_type(2)));
typedef unsigned u32x2 __attribute__((ext_vector_type(2)));
constexpr int PROJ_W = 4352;
constexpr float QSCALE = 0.125f * 1.4426950408889634f;
__device__ __forceinline__ float sigmoidf_(float v) { return 1.0f / (1.0f + __expf(-v)); }

struct EpiProj {
    static constexpr bool PERM = true, AFTER_DRAIN = false;
    bf16_t* P; const float* cs; const float* sn;
    __device__ __forceinline__ void operator()(const f32x4 (&acc)[2][2][4][2], const Unit& u, int wr, int wc, int fr, int fq) const {
        const int row0 = u.pm * BM + wr * 64 + fr;
#pragma unroll
        for (int bj = 0; bj < 2; ++bj) {
            const int ht = u.pn * 2 + bj;
            if (ht < 5) {
                const float sc = ht < 4 ? QSCALE : 1.0f;
                const int g4 = 4 * (4 * (wc & 1) + fq);
                const int cb = ht * 128 + (wc >> 1) * 64 + g4;
#pragma unroll
                for (int ai = 0; ai < 2; ++ai)
#pragma unroll
                    for (int m = 0; m < 4; ++m) {
                        const int row = row0 + ai * HALF + m * 16;
                        const f32x4 c = *(const f32x4*)(cs + (size_t)row * 32 + g4), s = *(const f32x4*)(sn + (size_t)row * 32 + g4);
                        const f32x4 x1 = acc[ai][bj][m][0], x2 = acc[ai][bj][m][1];
                        const f32x4 o1 = (x1 * c - x2 * s) * sc, o2 = (x2 * c + x1 * s) * sc;
                        u32x2 w1, w2; w1.x = cvt_pk_bf16(o1[0], o1[1]); w1.y = cvt_pk_bf16(o1[2], o1[3]); w2.x = cvt_pk_bf16(o2[0], o2[1]); w2.y = cvt_pk_bf16(o2[2], o2[3]);
                        bf16_t* rp = P + (size_t)row * PROJ_W + cb;
                        *(u32x2*)rp = w1; *(u32x2*)(rp + 32) = w2;
                    }
            } else {
                const int mode = (ht >= 18) ? 2 : ((ht >= 6 && ht < 10) ? 1 : 0);
                const float sc = mode == 1 ? QSCALE : 1.0f;
                const int col0 = ht * 128 + wc * 32 + 8 * fq;
#pragma unroll
                for (int ai = 0; ai < 2; ++ai)
#pragma unroll
                    for (int m = 0; m < 4; ++m) {
                        const int row = row0 + ai * HALF + m * 16;
                        f32x4 v0 = acc[ai][bj][m][0], v1 = acc[ai][bj][m][1];
                        if (mode == 2) {
#pragma unroll
                            for (int j = 0; j < 4; ++j) { v0[j] = sigmoidf_(v0[j]); v1[j] = sigmoidf_(v1[j]); }
                        } else { v0 = v0 * sc; v1 = v1 * sc; }
                        u32x4 w; w.x = cvt_pk_bf16(v0[0], v0[1]); w.y = cvt_pk_bf16(v0[2], v0[3]); w.z = cvt_pk_bf16(v1[0], v1[1]); w.w = cvt_pk_bf16(v1[2], v1[3]);
                        *(u32x4*)(P + (size_t)row * PROJ_W + col0) = w;
                    }
            }
        }
    }
};
__device__ __forceinline__ float bf_lo(unsigned w) { return __uint_as_float(w << 16); }
__device__ __forceinline__ float bf_hi(unsigned w) { return __uint_as_float(w & 0xffff0000u); }
template <bool SECOND> struct EpiBranch {
    static constexpr bool PERM = true, AFTER_DRAIN = false;
    bf16_t* O; const bf16_t* G;
    __device__ __forceinline__ void operator()(const f32x4 (&acc)[2][2][4][2], const Unit& u, int wr, int wc, int fr, int fq) const {
        const int row0 = u.pm * BM + wr * 64 + fr, col0 = u.pn * BM + wc * 32 + 8 * fq;
#pragma unroll
        for (int ai = 0; ai < 2; ++ai)
#pragma unroll
            for (int m = 0; m < 4; ++m) {
                const int row = row0 + ai * HALF + m * 16;
#pragma unroll
                for (int bj = 0; bj < 2; ++bj) {
                    const int col = col0 + bj * HALF;
                    const u32x4 g = *(const u32x4*)(G + (size_t)row * PROJ_W + col);
                    f32x4 v0 = acc[ai][bj][m][0], v1 = acc[ai][bj][m][1];
                    v0[0] *= bf_lo(g.x); v0[1] *= bf_hi(g.x); v0[2] *= bf_lo(g.y); v0[3] *= bf_hi(g.y);
                    v1[0] *= bf_lo(g.z); v1[1] *= bf_hi(g.z); v1[2] *= bf_lo(g.w); v1[3] *= bf_hi(g.w);
                    bf16_t* op = O + (size_t)row * 1024 + col;
                    if (SECOND) { const u32x4 p = *(const u32x4*)op;
                        v0[0] += bf_lo(p.x); v0[1] += bf_hi(p.x); v0[2] += bf_lo(p.y); v0[3] += bf_hi(p.y);
                        v1[0] += bf_lo(p.z); v1[1] += bf_hi(p.z); v1[2] += bf_lo(p.w); v1[3] += bf_hi(p.w); }
                    u32x4 w; w.x = cvt_pk_bf16(v0[0], v0[1]); w.y = cvt_pk_bf16(v0[2], v0[3]); w.z = cvt_pk_bf16(v1[0], v1[1]); w.w = cvt_pk_bf16(v1[2], v1[3]);
                    *(u32x4*)op = w;
                }
            }
    }
};
struct EpiF32 {
    static constexpr bool PERM = true, AFTER_DRAIN = false;
    float* O; int ldc;
    __device__ __forceinline__ void operator()(const f32x4 (&acc)[2][2][4][2], const Unit& u, int wr, int wc, int fr, int fq) const {
        const int row0 = u.pm * BM + wr * 64 + fr, col0 = u.pn * BM + wc * 32 + 8 * fq;
#pragma unroll
        for (int ai = 0; ai < 2; ++ai)
#pragma unroll
            for (int m = 0; m < 4; ++m) {
                float* rp = O + (size_t)(row0 + ai * HALF + m * 16) * ldc + col0;
#pragma unroll
                for (int bj = 0; bj < 2; ++bj) { *(f32x4*)(rp + bj * HALF) = acc[ai][bj][m][0]; *(f32x4*)(rp + bj * HALF + 4) = acc[ai][bj][m][1]; }
            }
    }
};
struct EpiSwiglu {
    static constexpr bool PERM = true, AFTER_DRAIN = false;
    bf16_t* O; int ldc;
    __device__ __forceinline__ void operator()(const f32x4 (&acc)[2][2][4][2], const Unit& u, int wr, int wc, int fr, int fq) const {
        const int row0 = u.pm * BM + wr * 64 + fr, col0 = u.pn * HALF + wc * 32 + 8 * fq;
#pragma unroll
        for (int ai = 0; ai < 2; ++ai)
#pragma unroll
            for (int m = 0; m < 4; ++m) {
                f32x4 v0, v1;
#pragma unroll
                for (int j = 0; j < 4; ++j) { const float g0 = acc[ai][0][m][0][j], g1 = acc[ai][0][m][1][j];
                    v0[j] = g0 * sigmoidf_(g0) * acc[ai][1][m][0][j]; v1[j] = g1 * sigmoidf_(g1) * acc[ai][1][m][1][j]; }
                u32x4 w; w.x = cvt_pk_bf16(v0[0], v0[1]); w.y = cvt_pk_bf16(v0[2], v0[3]); w.z = cvt_pk_bf16(v1[0], v1[1]); w.w = cvt_pk_bf16(v1[2], v1[3]);
                *(u32x4*)(O + (size_t)(row0 + ai * HALF + m * 16) * ldc + col0) = w;
            }
    }
};
template <class Epi, class Sched, bool ALIGN_EPI = false, bool SP2 = false>
__device__ __forceinline__ void gemm_phase(PG8_LAS unsigned char* lds, const Gemm g, const Sched& S, const Epi& E) {
    const int tid = threadIdx.x, wid = __builtin_amdgcn_readfirstlane(tid >> 6), lane = tid & 63, wr = wid >> 2, wc = wid & 3, fr = lane & 15, fq = lane >> 4;
    const int K = g.K, nt = K / BK;
    unsigned voffA[2], voffB[2];
#pragma unroll
    for (int i = 0; i < 2; ++i) { int R, C; stage_rc(tid * 16 + i * 8192, R, C); const int Rb = Epi::PERM ? ((R & ~31) + perm32(R & 31)) : R;
        voffA[i] = (unsigned)(R * K + C) * 2u; voffB[i] = (unsigned)(Rb * K + C) * 2u; }
    const size_t kstep = (size_t)(BK * 2);
    const size_t hstep = (size_t)HALF * K * 2;
    const size_t tstep = 2 * hstep;
    const unsigned ldsw = (unsigned)wid * 1024u;
    const int aoff = lds_byte(wr * 64 + fr, fq * 8), boff = lds_byte(wc * 32 + fr, fq * 8);
#define PG8_SA(b, h) (((b) * 2 + (h)) * HTB)
#define PG8_SB(b, h) ((4 + (b) * 2 + (h)) * HTB)
#define PG8_STAGE(bufoff, gbase, voff) do { _Pragma("unroll") for (int _i = 0; _i < 2; ++_i) \
        __builtin_amdgcn_global_load_lds((const unsigned*)((const char*)(gbase) + (voff)[_i]), (PG8_LAS unsigned*)(lds + (bufoff) + ldsw + _i * 8192), 16, 0, 0); } while (0)
#define PG8_LDA(dst, b, h) do { _Pragma("unroll") for (int m = 0; m < 4; ++m) _Pragma("unroll") for (int k = 0; k < 2; ++k) dst[m][k] = *(const PG8_LAS bf16x8*)(lds + PG8_SA(b, h) + aoff + m * 2048 + k * 1024); } while (0)
#define PG8_LDB(dst, b, h) do { _Pragma("unroll") for (int n = 0; n < 2; ++n) _Pragma("unroll") for (int k = 0; k < 2; ++k) dst[n][k] = *(const PG8_LAS bf16x8*)(lds + PG8_SB(b, h) + boff + n * 2048 + k * 1024); } while (0)
#define PG8_MMA(ai, bj, At, Bt) do { __builtin_amdgcn_s_setprio(1); _Pragma("unroll") for (int m = 0; m < 4; ++m) _Pragma("unroll") for (int n = 0; n < 2; ++n) _Pragma("unroll") for (int k = 0; k < 2; ++k) \
        acc[ai][bj][m][n] = __builtin_amdgcn_mfma_f32_16x16x32_bf16(Bt[n][k], At[m][k], acc[ai][bj][m][n], 0, 0, 0); __builtin_amdgcn_s_setprio(0); } while (0)
#define PG8_WAIT_V(n) asm volatile("s_waitcnt vmcnt(" #n ")" ::: "memory")
#define PG8_WAIT_L(n) asm volatile("s_waitcnt lgkmcnt(" #n ")" ::: "memory")
#define PG8_BAR __builtin_amdgcn_s_barrier()
#define PG8_SCHED __builtin_amdgcn_sched_barrier(0)
    Unit cur, nxt; int ui = 0;
    if (!S.next(0, cur)) return;
    f32x4 acc[2][2][4][2];
#pragma unroll
    for (int a = 0; a < 2; ++a)
#pragma unroll
        for (int b = 0; b < 2; ++b)
#pragma unroll
            for (int m = 0; m < 4; ++m)
#pragma unroll
                for (int n = 0; n < 2; ++n) acc[a][b][m][n] = (f32x4){0.f, 0.f, 0.f, 0.f};
    bf16x8 At[4][2], B0[2][2], B1[2][2];
    const char* cA = (const char*)g.A + (size_t)cur.pm * tstep; const char* cB = (const char*)g.Bt + (size_t)cur.pn * tstep;
    S.a_ready(cur);
    if constexpr (SP2) {
        PG8_STAGE(PG8_SB(0, 0), cB, voffB); PG8_STAGE(PG8_SB(0, 1), cB + hstep, voffB); PG8_STAGE(PG8_SA(0, 0), cA, voffA); PG8_STAGE(PG8_SA(0, 1), cA + hstep, voffA);
        if (wr == 1) PG8_BAR;
        PG8_WAIT_V(2); PG8_BAR;
        PG8_STAGE(PG8_SB(1, 0), cB + kstep, voffB); PG8_STAGE(PG8_SA(1, 0), cA + kstep, voffA); PG8_STAGE(PG8_SB(1, 1), cB + hstep + kstep, voffB);
        PG8_WAIT_V(6); PG8_BAR;
    } else {
        PG8_STAGE(PG8_SB(0, 0), cB, voffB); PG8_STAGE(PG8_SA(0, 0), cA, voffA); PG8_STAGE(PG8_SB(0, 1), cB + hstep, voffB); PG8_STAGE(PG8_SA(0, 1), cA + hstep, voffA);
        if (wr == 1) PG8_BAR;
        PG8_WAIT_V(4); PG8_BAR;
        PG8_STAGE(PG8_SB(1, 0), cB + kstep, voffB); PG8_STAGE(PG8_SA(1, 0), cA + kstep, voffA); PG8_STAGE(PG8_SB(1, 1), cB + hstep + kstep, voffB);
        PG8_WAIT_V(6); PG8_BAR;
    }
    for (;;) {
        const bool has_next = S.next(ui + 1, nxt);
        const char* nA = has_next ? (const char*)g.A + (size_t)nxt.pm * tstep : cA; const char* nB = has_next ? (const char*)g.Bt + (size_t)nxt.pn * tstep : cB;
        for (int t = 0; t < nt; t += 2) {
            const bool last = (t == nt - 2);
            const char* a1 = cA + (size_t)(t + 1) * kstep;
            const char* a2 = last ? nA : cA + (size_t)(t + 2) * kstep; const char* b2 = last ? nB : cB + (size_t)(t + 2) * kstep;
            const char* a3 = a2 + kstep; const char* b3 = b2 + kstep;
            if (last && has_next) S.a_ready(nxt);
            if constexpr (SP2) {
            PG8_LDB(B0, 0, 0); PG8_LDB(B1, 0, 1); PG8_SCHED; PG8_LDA(At, 0, 0); PG8_STAGE(PG8_SA(1, 1), a1 + hstep, voffA);
            PG8_WAIT_V(8); PG8_WAIT_L(0); PG8_BAR; PG8_MMA(0, 0, At, B0); PG8_MMA(0, 1, At, B1); PG8_BAR; PG8_SCHED;
            PG8_LDA(At, 0, 1); PG8_STAGE(PG8_SB(0, 0), b2, voffB); PG8_STAGE(PG8_SB(0, 1), b2 + hstep, voffB); PG8_STAGE(PG8_SA(0, 0), a2, voffA);
            PG8_WAIT_V(8); PG8_WAIT_L(0); PG8_BAR; PG8_MMA(1, 0, At, B0); PG8_MMA(1, 1, At, B1); PG8_BAR; PG8_SCHED;
            PG8_LDB(B0, 1, 0); PG8_LDB(B1, 1, 1); PG8_SCHED; PG8_LDA(At, 1, 0); PG8_STAGE(PG8_SA(0, 1), a2 + hstep, voffA);
            PG8_WAIT_V(8); PG8_WAIT_L(0); PG8_BAR; PG8_MMA(0, 0, At, B0); PG8_MMA(0, 1, At, B1); PG8_BAR; PG8_SCHED;
            PG8_LDA(At, 1, 1); PG8_STAGE(PG8_SB(1, 0), b3, voffB); PG8_STAGE(PG8_SB(1, 1), b3 + hstep, voffB); PG8_STAGE(PG8_SA(1, 0), a3, voffA);
            PG8_WAIT_V(8); PG8_WAIT_L(0); PG8_BAR; PG8_MMA(1, 0, At, B0); PG8_MMA(1, 1, At, B1); PG8_BAR; PG8_SCHED;
            } else {
            PG8_LDB(B0, 0, 0); PG8_SCHED; PG8_LDA(At, 0, 0); PG8_STAGE(PG8_SA(1, 1), a1 + hstep, voffA);
            PG8_WAIT_L(8); PG8_BAR; PG8_WAIT_L(0); PG8_MMA(0, 0, At, B0); PG8_BAR; PG8_SCHED;
            PG8_LDB(B1, 0, 1); PG8_STAGE(PG8_SB(0, 0), b2, voffB);
            PG8_BAR; PG8_WAIT_L(0); PG8_MMA(0, 1, At, B1); PG8_BAR;
            PG8_LDA(At, 0, 1); PG8_STAGE(PG8_SA(0, 0), a2, voffA);
            PG8_BAR; PG8_WAIT_L(0); PG8_MMA(1, 0, At, B0); PG8_BAR; PG8_SCHED;
            PG8_STAGE(PG8_SB(0, 1), b2 + hstep, voffB);
            PG8_WAIT_V(6); PG8_BAR; PG8_MMA(1, 1, At, B1); PG8_BAR;
            PG8_LDB(B0, 1, 0); PG8_SCHED; PG8_LDA(At, 1, 0); PG8_STAGE(PG8_SA(0, 1), a2 + hstep, voffA);
            PG8_WAIT_L(8); PG8_BAR; PG8_WAIT_L(0); PG8_MMA(0, 0, At, B0); PG8_BAR; PG8_SCHED;
            PG8_LDB(B1, 1, 1); PG8_STAGE(PG8_SB(1, 0), b3, voffB);
            PG8_BAR; PG8_WAIT_L(0); PG8_MMA(0, 1, At, B1); PG8_BAR;
            PG8_LDA(At, 1, 1); PG8_STAGE(PG8_SA(1, 0), a3, voffA);
            PG8_BAR; PG8_WAIT_L(0); PG8_MMA(1, 0, At, B0); PG8_BAR; PG8_SCHED;
            PG8_STAGE(PG8_SB(1, 1), b3 + hstep, voffB);
            PG8_WAIT_V(6); PG8_BAR; PG8_MMA(1, 1, At, B1); PG8_BAR;
            }
        }
        if constexpr (ALIGN_EPI) { if (wr == 0) PG8_BAR; }
        if constexpr (!Epi::AFTER_DRAIN) { E(acc, cur, wr, wc, fr, fq); S.done(cur); }
        if (!has_next) break;
#pragma unroll
        for (int a = 0; a < 2; ++a)
#pragma unroll
            for (int b = 0; b < 2; ++b)
#pragma unroll
                for (int m = 0; m < 4; ++m)
#pragma unroll
                    for (int n = 0; n < 2; ++n) acc[a][b][m][n] = (f32x4){0.f, 0.f, 0.f, 0.f};
        cur = nxt; cA = nA; cB = nB; ++ui;
        if constexpr (ALIGN_EPI) { if (wr == 1) PG8_BAR; }
    }
    PG8_WAIT_V(0);
    if constexpr (!ALIGN_EPI) { if (wr == 0) PG8_BAR; }
    PG8_BAR;
    if constexpr (Epi::AFTER_DRAIN) { E.fused(acc, cur, wr, wc, fr, fq, lds, wid, lane); S.done(cur); }
#undef PG8_SA
#undef PG8_SB
#undef PG8_STAGE
#undef PG8_LDA
#undef PG8_LDB
#undef PG8_MMA
#undef PG8_WAIT_V
#undef PG8_WAIT_L
#undef PG8_BAR
#undef PG8_SCHED
}
}

namespace att {
#define ALAS __attribute__((address_space(3)))
typedef unsigned short bf16;
typedef short bf16x8 __attribute__((ext_vector_type(8)));
typedef short s16x4 __attribute__((ext_vector_type(4)));
typedef float f32x16 __attribute__((ext_vector_type(16)));
typedef float f32x4 __attribute__((ext_vector_type(4)));
typedef float f32x2 __attribute__((ext_vector_type(2)));
typedef __bf16 bf16x2_t __attribute__((ext_vector_type(2)));
typedef unsigned u32x4 __attribute__((ext_vector_type(4)));
typedef unsigned u32x2 __attribute__((ext_vector_type(2)));
constexpr int PITCH = 4352, OPITCH = 512, BUFB = 16640;
__device__ __forceinline__ unsigned cvtpk(float lo, float hi) { f32x2 v = {lo, hi}; bf16x2_t b = __builtin_convertvector(v, bf16x2_t); return __builtin_bit_cast(unsigned, b); }
__device__ __forceinline__ s16x4 vtr(const ALAS unsigned char* p) { return __builtin_bit_cast(s16x4, __builtin_amdgcn_ds_read_tr16_b64_v4i16((ALAS s16x4*)p)); }
__device__ __forceinline__ int crow(int i, int h) { return (i & 3) + 8 * (i >> 2) + 4 * h; }

template <int MODE>
__device__ __forceinline__ void attn_unit(ALAS unsigned char* shm, const bf16* Qp, const bf16* Kp, const bf16* Vp, bf16* Op, const float* biasp, float m_init, int q0, int t_lo, int t_hi) {
    const int tid = threadIdx.x, lane = tid & 63, r = lane & 31, h = lane >> 5;
    const int wid = __builtin_amdgcn_readfirstlane(tid >> 6);
    const int qw0 = q0 + wid * 32, qrow = qw0 + r;
    const bf16* ksrc = Kp + (size_t)lane * PITCH + wid * 8;
    const bf16* vsrc = Vp + (size_t)(16 * (wid & 3) + (lane >> 2)) * PITCH + (wid >> 2) * 32 + (lane & 3) * 8;
    const int sdst = wid * 1024 + lane * 16;
    bf16x8 qr[4];
#pragma unroll
    for (int d0 = 0; d0 < 4; ++d0) qr[d0] = *(const bf16x8*)(Qp + (size_t)qrow * PITCH + d0 * 16 + h * 8);
    f32x16 o0, o1;
#pragma unroll
    for (int i = 0; i < 16; ++i) { o0[i] = 0.f; o1[i] = 0.f; }
    float m = m_init, l = (MODE == 1 && h == 0) ? 1.0f : 0.0f;
    u32x4 kreg, vreg; float breg = 0.f;
    kreg = *(const u32x4*)(ksrc + (size_t)t_lo * 64 * PITCH); vreg = *(const u32x4*)(vsrc + (size_t)t_lo * 64 * PITCH);
    if (MODE == 0 && tid < 64) breg = biasp[t_lo * 64 + tid];
    *(ALAS u32x4*)(shm + sdst) = kreg; *(ALAS u32x4*)(shm + 8192 + sdst) = vreg;
    if (MODE == 0 && tid < 64) *(ALAS float*)(shm + 16384 + tid * 4) = breg;
    __syncthreads();
    const int nt = t_hi - t_lo;
    for (int it = 0; it < nt; ++it) {
        const int t = t_lo + it;
        ALAS unsigned char* buf = shm + (it & 1) * BUFB;
        const bool more = it + 1 < nt;
        if (more) { kreg = *(const u32x4*)(ksrc + (size_t)(t + 1) * 64 * PITCH); vreg = *(const u32x4*)(vsrc + (size_t)(t + 1) * 64 * PITCH);
                    if (MODE == 0 && tid < 64) breg = biasp[(t + 1) * 64 + tid]; }
        const int k0 = t * 64;
        const bool need = (k0 <= qw0 + 31) && (MODE == 0 || (k0 + 63 >= qw0 - 127));
        if (need) {
            f32x16 s0, s1;
#pragma unroll
            for (int i = 0; i < 16; ++i) { s0[i] = 0.f; s1[i] = 0.f; }
#pragma unroll
            for (int d0 = 0; d0 < 4; ++d0) {
                const bf16x8 ka = *(const ALAS bf16x8*)(buf + (2 * d0 + h) * 1024 + r * 16);
                const bf16x8 kb = *(const ALAS bf16x8*)(buf + (2 * d0 + h) * 1024 + (32 + r) * 16);
                s0 = __builtin_amdgcn_mfma_f32_32x32x16_bf16(ka, qr[d0], s0, 0, 0, 0);
                s1 = __builtin_amdgcn_mfma_f32_32x32x16_bf16(kb, qr[d0], s1, 0, 0, 0);
            }
            if (MODE == 0) {
#pragma unroll
                for (int g = 0; g < 4; ++g) {
                    const f32x4 b0 = *(const ALAS f32x4*)(buf + 16384 + (8 * g + 4 * h) * 4), b1 = *(const ALAS f32x4*)(buf + 16384 + (32 + 8 * g + 4 * h) * 4);
#pragma unroll
                    for (int j = 0; j < 4; ++j) { s0[4 * g + j] += b0[j]; s1[4 * g + j] += b1[j]; }
                }
            }
            const bool boundary = (MODE == 1) || (k0 + 63 > qw0);
            if (boundary) {
#pragma unroll
                for (int i = 0; i < 16; ++i) {
                    const int ka0 = k0 + crow(i, h), ka1 = ka0 + 32;
                    const bool v0 = (ka0 <= qrow) && (MODE == 0 || (qrow - ka0 < 128));
                    const bool v1 = (ka1 <= qrow) && (MODE == 0 || (qrow - ka1 < 128));
                    s0[i] = v0 ? s0[i] : -INFINITY; s1[i] = v1 ? s1[i] : -INFINITY;
                }
            }
            float mx = fmaxf(s0[0], s1[0]);
#pragma unroll
            for (int i = 1; i < 16; ++i) mx = fmaxf(mx, fmaxf(s0[i], s1[i]));
            mx = fmaxf(mx, __shfl_xor(mx, 32));
            const float mn = fmaxf(m, mx);
            const float alpha = __builtin_amdgcn_exp2f(m - mn);
            m = mn;
            float ps = 0.f;
#pragma unroll
            for (int i = 0; i < 16; ++i) { s0[i] = __builtin_amdgcn_exp2f(s0[i] - mn); s1[i] = __builtin_amdgcn_exp2f(s1[i] - mn); ps += s0[i] + s1[i]; }
            l = l * alpha + ps;
#pragma unroll
            for (int i = 0; i < 16; ++i) { o0[i] *= alpha; o1[i] *= alpha; }
            const ALAS unsigned char* vb = buf + 8192 + (4 * h + ((lane & 15) >> 2)) * 64 + ((lane >> 4) & 1) * 32 + (lane & 3) * 8;
#pragma unroll
            for (int sb = 0; sb < 2; ++sb)
#pragma unroll
                for (int ks = 0; ks < 2; ++ks) {
                    u32x4 pw;
                    if (sb == 0) { pw.x = cvtpk(s0[8 * ks + 0], s0[8 * ks + 1]); pw.y = cvtpk(s0[8 * ks + 2], s0[8 * ks + 3]); pw.z = cvtpk(s0[8 * ks + 4], s0[8 * ks + 5]); pw.w = cvtpk(s0[8 * ks + 6], s0[8 * ks + 7]); }
                    else         { pw.x = cvtpk(s1[8 * ks + 0], s1[8 * ks + 1]); pw.y = cvtpk(s1[8 * ks + 2], s1[8 * ks + 3]); pw.z = cvtpk(s1[8 * ks + 4], s1[8 * ks + 5]); pw.w = cvtpk(s1[8 * ks + 6], s1[8 * ks + 7]); }
                    const bf16x8 pf = __builtin_bit_cast(bf16x8, pw);
                    const ALAS unsigned char* vp = vb + (32 * sb + 16 * ks) * 64;
                    const s16x4 a0 = vtr(vp), a1 = vtr(vp + 512), c0 = vtr(vp + 4096), c1 = vtr(vp + 4096 + 512);
                    const bf16x8 vf0 = {a0[0], a0[1], a0[2], a0[3], a1[0], a1[1], a1[2], a1[3]};
                    const bf16x8 vf1 = {c0[0], c0[1], c0[2], c0[3], c1[0], c1[1], c1[2], c1[3]};
                    o0 = __builtin_amdgcn_mfma_f32_32x32x16_bf16(vf0, pf, o0, 0, 0, 0);
                    o1 = __builtin_amdgcn_mfma_f32_32x32x16_bf16(vf1, pf, o1, 0, 0, 0);
                }
        }
        if (more) {
            ALAS unsigned char* nb = shm + ((it + 1) & 1) * BUFB;
            *(ALAS u32x4*)(nb + sdst) = kreg; *(ALAS u32x4*)(nb + 8192 + sdst) = vreg;
            if (MODE == 0 && tid < 64) *(ALAS float*)(nb + 16384 + tid * 4) = breg;
        }
        __syncthreads();
    }
    const float lt = l + __shfl_xor(l, 32);
    const float inv = 1.0f / lt;
    bf16* orow = Op + (size_t)qrow * OPITCH;
#pragma unroll
    for (int g = 0; g < 4; ++g) {
        u32x2 w0, w1;
        w0.x = cvtpk(o0[4 * g + 0] * inv, o0[4 * g + 1] * inv); w0.y = cvtpk(o0[4 * g + 2] * inv, o0[4 * g + 3] * inv);
        w1.x = cvtpk(o1[4 * g + 0] * inv, o1[4 * g + 1] * inv); w1.y = cvtpk(o1[4 * g + 2] * inv, o1[4 * g + 3] * inv);
        *(u32x2*)(orow + 8 * g + 4 * h) = w0; *(u32x2*)(orow + 32 + 8 * g + 4 * h) = w1;
    }
}
}
#define GAS __attribute__((address_space(1)))
#define LAS __attribute__((address_space(3)))
typedef unsigned short bf16;
typedef unsigned v4u __attribute__((ext_vector_type(4)));
typedef float f32x4 __attribute__((ext_vector_type(4)));
constexpr int NWAVES = 8, NTHR = NWAVES * 64;
constexpr int BATCH = 8, SEQ = 4096, D = 1024, M = BATCH * SEQ, DFF = 2816, INW = 4360, PROJW = 4352, NADA = 6;
constexpr float RMS_EPS = 1e-6f, LOG2E = 1.4426950408889634f;
constexpr size_t MiB = 1u << 20;
constexpr size_t WS_ADA = 1 * MiB;
constexpr size_t WS_WF = WS_ADA + 256 * 1024;
constexpr size_t WS_LOGF = 2 * MiB;
constexpr size_t WS_CUM = 3 * MiB;
constexpr size_t WS_COS = 4 * MiB, WS_SIN = 8 * MiB;
constexpr size_t WS_WIN = 12 * MiB;
constexpr size_t WS_WA = 21 * MiB, WS_WB = 22 * MiB;
constexpr size_t WS_WOUT = 23 * MiB;
constexpr size_t WS_WFI = 25 * MiB;
constexpr size_t WS_WFO = 36 * MiB;
constexpr size_t WS_H = 48 * MiB;
constexpr size_t WS_MERGED = 112 * MiB;
constexpr size_t WS_PROJ = 176 * MiB;
constexpr size_t WS_END = 448 * MiB;
constexpr int LDS_BYTES = 147456;

__device__ __forceinline__ unsigned f2bf(float f) { unsigned u = __builtin_bit_cast(unsigned, f); return (u + 0x7fffu + ((u >> 16) & 1u)) >> 16; }
__device__ __forceinline__ unsigned pk2(float lo, float hi) { return f2bf(lo) | (f2bf(hi) << 16); }
__device__ __forceinline__ float wave_sum(float v) {
#pragma unroll
    for (int o = 1; o < 64; o <<= 1) v += __shfl_xor(v, o);
    return v;
}
#define XB_TMO      128
#define XB_XCNT(j)  (256  + 64 * (j))
#define XB_XSUB(j)  (1280 + 64 * (j))
#define XB_XGEN(j)  (2304 + 64 * (j))
#define XB_TOP      3328
#define XB_TOPGEN   3392
#define XCD_BAR_WORDS 3456
#define XB_SPIN_CAP (1u << 18)

__device__ __forceinline__ unsigned xb_ld(unsigned* p)              { return __hip_atomic_load(p, __ATOMIC_RELAXED, __HIP_MEMORY_SCOPE_AGENT); }
__device__ __forceinline__ unsigned xb_add(unsigned* p, unsigned v) { return __hip_atomic_fetch_add(p, v, __ATOMIC_RELAXED, __HIP_MEMORY_SCOPE_AGENT); }
__device__ __forceinline__ unsigned xb_xcc_id() { return (unsigned)__builtin_amdgcn_s_getreg((3 << 11) | 20) & 0xFu; }
#define XB_SPIN(cond, bar) do { unsigned _sp = 0; while (cond) { __builtin_amdgcn_s_sleep(1); \
    if ((++_sp & 255u) == 0u) { if (xb_ld(&(bar)[XB_TMO])) break; if (_sp > XB_SPIN_CAP) { atomicAdd(&(bar)[XB_TMO], 1u); break; } } } } while (0)

struct XcdBarrier {
    unsigned* bar; unsigned x;
    volatile LAS unsigned* st;
};

__device__ __forceinline__ XcdBarrier xcd_barrier_post(unsigned* bar, volatile LAS unsigned* st) {
    XcdBarrier b; b.bar = bar; b.x = xb_xcc_id(); b.st = st;
    if (threadIdx.x == 0) (void)xb_add(&bar[XB_XCNT(b.x)], 1u);
    return b;
}
__device__ __forceinline__ void xcd_barrier_complete(unsigned* bar, unsigned x, unsigned& nloc, unsigned& nx) {
    const unsigned G = gridDim.x * gridDim.y * gridDim.z;
    unsigned sum, cnt, mine, sp = 0u;
    for (;;) {
        sum = 0u; cnt = 0u; mine = 0u;
#pragma unroll
        for (unsigned j = 0; j < 16; ++j) { const unsigned c = xb_ld(&bar[XB_XCNT(j)]); sum += c; cnt += (c > 0u) ? 1u : 0u; mine = (j == x) ? c : mine; }
        if (sum == G) break;
        __builtin_amdgcn_s_sleep(1);
        if ((++sp & 255u) == 0u) { if (xb_ld(&bar[XB_TMO])) break; if (sp > XB_SPIN_CAP) { atomicAdd(&bar[XB_TMO], 1u); break; } }
    }
    nloc = mine > 0u ? mine : 1u; nx = cnt > 0u ? cnt : 1u;
}

__device__ __forceinline__ void xcd_barrier(const XcdBarrier& b) {
    asm volatile("s_waitcnt vmcnt(0)" ::: "memory");
    __syncthreads();
    if (threadIdx.x == 0) {
        unsigned* bar = b.bar;
        __builtin_amdgcn_s_waitcnt(0);
        unsigned nloc = b.st[0], nx = b.st[1];
        if (nloc == 0u) { xcd_barrier_complete(bar, b.x, nloc, nx); b.st[0] = nloc; b.st[1] = nx; }
        const unsigned old = xb_add(&bar[XB_XSUB(b.x)], 1u);
        const unsigned gen = old / nloc;
        if (old + 1u == (gen + 1u) * nloc) {
            __builtin_amdgcn_fence(__ATOMIC_RELEASE, "agent");
            asm volatile("s_waitcnt vmcnt(0)" ::: "memory");
            const unsigned og = xb_add(&bar[XB_TOP], 1u);
            const unsigned tg = og / nx;
            if (og + 1u == (tg + 1u) * nx) xb_add(&bar[XB_TOPGEN], 1u);
            else XB_SPIN(xb_ld(&bar[XB_TOPGEN]) == tg, bar);
            __builtin_amdgcn_fence(__ATOMIC_ACQUIRE, "agent");
            xb_add(&bar[XB_XGEN(b.x)], 1u);
            asm volatile("s_waitcnt vmcnt(0)" ::: "memory");
        } else {
            XB_SPIN(xb_ld(&bar[XB_XGEN(b.x)]) == gen, bar);
            __builtin_amdgcn_fence(__ATOMIC_ACQUIRE, "agent");
            asm volatile("s_waitcnt vmcnt(0)" ::: "memory");
        }
    }
    __syncthreads();
}

template <class CM>
__device__ __forceinline__ void transpose_item(const float* W, int K, int ldw, int Nst, bf16* WT, LAS float* scr, int item, int lane, CM cm) {
    const int nblk = Nst / 32, kb = item / nblk, nb = item % nblk, k0 = 64 * kb, n0 = 32 * nb;
    const int sc = cm(n0 + (lane & 31));
#pragma unroll 8
    for (int i = 0; i < 32; ++i) { const int kk = 2 * i + (lane >> 5); scr[kk * 33 + (lane & 31)] = W[(size_t)(k0 + kk) * ldw + sc]; }
    asm volatile("s_waitcnt lgkmcnt(0)" ::: "memory");
    const int c = lane & 7;
#pragma unroll
    for (int j = 0; j < 4; ++j) { const int n = (lane >> 3) + 8 * j; const LAS float* s = scr + (8 * c) * 33 + n;
        v4u o; o.x = pk2(s[0 * 33], s[1 * 33]); o.y = pk2(s[2 * 33], s[3 * 33]); o.z = pk2(s[4 * 33], s[5 * 33]); o.w = pk2(s[6 * 33], s[7 * 33]);
        *(v4u*)(WT + (size_t)(n0 + n) * K + k0 + 8 * c) = o; }
    asm volatile("s_waitcnt lgkmcnt(0)" ::: "memory");
}
struct CmId { __device__ __forceinline__ int operator()(int n) const { return n; } };
struct CmWin { __device__ __forceinline__ int operator()(int n) const {
    if (n < 640) { const int p = n & 63, g = p >> 3, e = p & 7; return (n & ~63) + ((e < 4) ? (4 * g + e) : (32 + 4 * g + (e - 4))); }
    return n < 2304 ? n : n + 8; } };
struct CmFfn { __device__ __forceinline__ int operator()(int n) const { const int t = n >> 8, w = n & 255; return (w < 128) ? (128 * t + w) : (DFF + 128 * t + (w - 128)); } };

struct Args { const void* in[17]; float* out; unsigned char* ws; };

__device__ __forceinline__ float log_sigmoid_(float z) { return z >= 0.f ? -log1pf(__expf(-z)) : z - log1pf(__expf(z)); }

__global__ void __launch_bounds__(NTHR, 2) mega_fwd(Args args) {
    extern __shared__ __attribute__((aligned(16))) unsigned char lds_raw[];
    LAS unsigned char* lds = (LAS unsigned char*)lds_raw;
    cg::grid_group grid = cg::this_grid();
    const int tid = threadIdx.x, lane = tid & 63, wave = __builtin_amdgcn_readfirstlane(tid >> 6);
    const int G = gridDim.x, bx = blockIdx.x;
    const int vcu = (G % 8 == 0) ? (bx % 8) * (G / 8) + bx / 8 : bx;
    const int gw = vcu * NWAVES + wave, NGW = G * NWAVES;
    unsigned char* ws = args.ws;
    const float* x = (const float*)args.in[0]; const float* cvec = (const float*)args.in[1]; const int* positions = (const int*)args.in[2];
    const float* w_ada = (const float*)args.in[3]; const float* b_ada = (const float*)args.in[4];
    const float* g_pre_mix = (const float*)args.in[5]; const float* g_post_mix = (const float*)args.in[6];
    const float* w_in = (const float*)args.in[7]; const float* b_f = (const float*)args.in[8]; const float* sinks = (const float*)args.in[9];
    const float* w_branch_a = (const float*)args.in[10]; const float* w_branch_b = (const float*)args.in[11]; const float* w_out = (const float*)args.in[12];
    const float* g_pre_ffn = (const float*)args.in[13]; const float* g_post_ffn = (const float*)args.in[14];
    const float* w_ffn_in = (const float*)args.in[15]; const float* w_ffn_out = (const float*)args.in[16];
    float* out = args.out;
    float* ADA = (float*)(ws + WS_ADA); float* WF = (float*)(ws + WS_WF); float* LOGF = (float*)(ws + WS_LOGF); float* CUM = (float*)(ws + WS_CUM);
    float* COS = (float*)(ws + WS_COS); float* SIN = (float*)(ws + WS_SIN);
    bf16* WIN = (bf16*)(ws + WS_WIN); bf16* WA = (bf16*)(ws + WS_WA); bf16* WB = (bf16*)(ws + WS_WB); bf16* WOUT = (bf16*)(ws + WS_WOUT);
    bf16* WFI = (bf16*)(ws + WS_WFI); bf16* WFO = (bf16*)(ws + WS_WFO);
    bf16* H = (bf16*)(ws + WS_H); bf16* OA = (bf16*)(ws + WS_H); bf16* OB = OA + (size_t)M * 512; bf16* H2 = (bf16*)(ws + WS_H); float* Y2 = (float*)(ws + WS_H);
    bf16* MERGED = (bf16*)(ws + WS_MERGED);
    bf16* PROJ = (bf16*)(ws + WS_PROJ); float* Y = (float*)(ws + WS_PROJ); bf16* ACT = (bf16*)(ws + WS_PROJ);

    volatile LAS unsigned* MISC = (volatile LAS unsigned*)(lds + 131072 + 320);
    if (tid < 32) MISC[tid] = 0u;
    unsigned* barw = (unsigned*)ws;
    if (bx == 0) for (int i = tid; i < XCD_BAR_WORDS; i += NTHR) barw[i] = 0u;
    __syncthreads();
    {
        LAS float* cl = (LAS float*)lds;
        LAS float* part = (LAS float*)(lds + 32768);
        for (int i = tid; i < 8 * 1024; i += NTHR) { const int b = i >> 10, k = i & 1023; cl[k * 8 + b] = cvec[i]; }
        __syncthreads();
        for (int ch = vcu; ch < 256; ch += G) {
            const int n0 = 24 * ch;
            if (tid < 504) {
                const int col = tid % 24, kg = tid / 24;
                float a[8];
#pragma unroll
                for (int b = 0; b < 8; ++b) a[b] = 0.f;
                for (int k = kg; k < 1024; k += 21) {
                    const float w = w_ada[(size_t)k * (NADA * D) + n0 + col];
                    const f32x4 c0 = *(const LAS f32x4*)(cl + k * 8), c1 = *(const LAS f32x4*)(cl + k * 8 + 4);
                    a[0] += w * c0[0]; a[1] += w * c0[1]; a[2] += w * c0[2]; a[3] += w * c0[3];
                    a[4] += w * c1[0]; a[5] += w * c1[1]; a[6] += w * c1[2]; a[7] += w * c1[3];
                }
#pragma unroll
                for (int b = 0; b < 8; ++b) part[(kg * 24 + col) * 8 + b] = a[b];
            }
            __syncthreads();
            if (tid < 192) {
                const int col = tid >> 3, b = tid & 7; float s = b_ada[n0 + col];
                for (int kg = 0; kg < 21; ++kg) s += part[(kg * 24 + col) * 8 + b];
                ADA[b * (NADA * D) + n0 + col] = s;
            }
            __syncthreads();
        }
        LAS float* scr = (LAS float*)(lds + wave * 16384);
        constexpr int I_IN = (D / 64) * (PROJW / 32), I_A = (512 / 64) * (D / 32), I_O = (D / 64) * (D / 32), I_FI = (D / 64) * (2 * DFF / 32), I_FO = (DFF / 64) * (D / 32);
        constexpr int NITEMS = I_IN + 2 * I_A + I_O + I_FI + I_FO;
        for (int it = gw; it < NITEMS; it += NGW) {
            int r = it;
            if (r < I_IN) { transpose_item(w_in, D, INW, PROJW, WIN, scr, r, lane, CmWin()); continue; } r -= I_IN;
            if (r < I_A) { transpose_item(w_branch_a, 512, D, D, WA, scr, r, lane, CmId()); continue; } r -= I_A;
            if (r < I_A) { transpose_item(w_branch_b, 512, D, D, WB, scr, r, lane, CmId()); continue; } r -= I_A;
            if (r < I_O) { transpose_item(w_out, D, D, D, WOUT, scr, r, lane, CmId()); continue; } r -= I_O;
            if (r < I_FI) { transpose_item(w_ffn_in, D, 2 * DFF, 2 * DFF, WFI, scr, r, lane, CmFfn()); continue; } r -= I_FI;
            transpose_item(w_ffn_out, DFF, D, D, WFO, scr, r, lane, CmId());
        }
        for (int i = vcu * NTHR + tid; i < 8 * 1024; i += G * NTHR) { const int j = i >> 10, k = i & 1023; WF[i] = w_in[(size_t)k * INW + 2304 + j]; }
        for (int i = vcu * NTHR + tid; i < M * 32; i += G * NTHR) {
            const int row = i >> 5, f = i & 31;
            const double inv_freq = exp(-(double)f * (9.210340371976184 / 32.0));
            const double ang = (double)positions[row] * inv_freq;
            const double qd = rint(ang * 0.6366197723675814);
            const double rr = fma(-qd, 1.5707963267948966, ang) - qd * 6.123233995736766e-17;
            const double r2 = rr * rr;
            const double sp = rr * (1.0 + r2 * (-1.0 / 6 + r2 * (1.0 / 120 + r2 * (-1.0 / 5040 + r2 * (1.0 / 362880 + r2 * (-1.0 / 39916800 + r2 * (1.0 / 6227020800.0)))))));
            const double cp = 1.0 + r2 * (-0.5 + r2 * (1.0 / 24 + r2 * (-1.0 / 720 + r2 * (1.0 / 40320 + r2 * (-1.0 / 3628800 + r2 * (1.0 / 479001600.0 + r2 * (-1.0 / 87178291200.0)))))));
            const int qi = ((int)qd) & 3;
            const double sv = (qi == 0) ? sp : (qi == 1) ? cp : (qi == 2) ? -sp : -cp;
            const double cv = (qi == 0) ? cp : (qi == 1) ? -sp : (qi == 2) ? -cp : sp;
            COS[i] = (float)cv; SIN[i] = (float)sv;
        }
    }
    grid.sync();
    XcdBarrier bar = xcd_barrier_post(barw, MISC + 8);

    {
        LAS float* wf = (LAS float*)lds;
        for (int i = tid; i < 8 * 1024; i += NTHR) wf[i] = WF[i];
        __syncthreads();
        for (int row = gw; row < M; row += NGW) {
            const int b = row / SEQ;
            const f32x4* xr = (const f32x4*)(x + (size_t)row * D) + lane;
            const float* ada = ADA + b * (NADA * D);
            f32x4 v[4]; float ss = 0.f;
#pragma unroll
            for (int j = 0; j < 4; ++j) { v[j] = xr[64 * j]; ss += (v[j][0] * v[j][0] + v[j][1] * v[j][1]) + (v[j][2] * v[j][2] + v[j][3] * v[j][3]); }
            const float rstd = 1.0f / sqrtf(wave_sum(ss) * (1.0f / D) + RMS_EPS);
            float fl[8];
#pragma unroll
            for (int jj = 0; jj < 8; ++jj) fl[jj] = 0.f;
            unsigned long long* o8 = (unsigned long long*)(H + (size_t)row * D) + lane;
#pragma unroll
            for (int j = 0; j < 4; ++j) {
                const int cidx = 4 * (lane + 64 * j);
                const f32x4 g = *(const f32x4*)(g_pre_mix + cidx), sc = *(const f32x4*)(ada + 1 * D + cidx), sh = *(const f32x4*)(ada + 0 * D + cidx);
                const f32x4 hv = v[j] * rstd * g * (sc + 1.0f) + sh;
#pragma unroll
                for (int jj = 0; jj < 8; ++jj) { const f32x4 w = *(const LAS f32x4*)(wf + jj * 1024 + cidx); fl[jj] += (hv[0] * w[0] + hv[1] * w[1]) + (hv[2] * w[2] + hv[3] * w[3]); }
                o8[64 * j] = (unsigned long long)pk2(hv[0], hv[1]) | ((unsigned long long)pk2(hv[2], hv[3]) << 32);
            }
            float mine = 0.f;
#pragma unroll
            for (int jj = 0; jj < 8; ++jj) { const float s = wave_sum(fl[jj]); if (lane == jj) mine = s; }
            if (lane < 8) LOGF[(size_t)row * 8 + lane] = log_sigmoid_(mine + b_f[lane]);
        }
    }
    xcd_barrier(bar);

    {
        LAS float* wt = (LAS float*)lds;
        for (int bh = bx; bh < BATCH * 8; bh += G) {
            const int b = bh >> 3, hh = bh & 7;
            float vals[8]; float run = 0.f;
#pragma unroll
            for (int e = 0; e < 8; ++e) { run += LOGF[((size_t)b * SEQ + tid * 8 + e) * 8 + hh]; vals[e] = run; }
            float inc = run;
#pragma unroll
            for (int o = 1; o < 64; o <<= 1) { const float nb = __shfl_up(inc, o); if (lane >= o) inc += nb; }
            if (lane == 63) wt[wave] = inc;
            __syncthreads();
            float base = inc - run;
            for (int w = 0; w < wave; ++w) base += wt[w];
#pragma unroll
            for (int e = 0; e < 8; ++e) CUM[(size_t)bh * SEQ + tid * 8 + e] = -(base + vals[e]) * LOG2E;
            __syncthreads();
        }
        pg8::Gemm g{H, WIN, M, PROJW, D}; pg8::StaticOrder S; S.init(M, PROJW, G, bx);
        pg8::EpiProj E{PROJ, COS, SIN};
        pg8::gemm_phase<pg8::EpiProj, pg8::StaticOrder, true, true>(lds, g, S, E);
    }
    xcd_barrier(bar);

    {
        for (int j = vcu; j < 256; j += G) {
            const int bh = j >> 2, s = j & 3, b = bh >> 3, hh = bh & 7;
            const bf16* base = PROJ + (size_t)b * SEQ * PROJW;
#pragma unroll 1
            for (int k = 0; k < 4; ++k) {
                const int qb = (k == 0) ? 15 - s : (k == 1) ? 8 + s : (k == 2) ? 7 - s : s;
                att::attn_unit<0>(lds, base + 768 + hh * 64, base + 1280 + hh * 64, base + 1792 + hh * 64, OB + (size_t)b * SEQ * 512 + hh * 64,
                                  CUM + (size_t)bh * SEQ, -1e30f, qb * 256, 0, 4 * qb + 4);
            }
        }
        for (int j = vcu; j < 256; j += G) {
#pragma unroll 1
            for (int k = 0; k < 4; ++k) {
                const int u = 4 * j + k, qb = u & 15, qh = (u >> 4) & 7, b = u >> 7;
                const bf16* base = PROJ + (size_t)b * SEQ * PROJW;
                const int tlo = (4 * qb - 2) > 0 ? (4 * qb - 2) : 0;
                att::attn_unit<1>(lds, base + qh * 64, base + 512 + (qh >> 2) * 64, base + 640 + (qh >> 2) * 64, OA + (size_t)b * SEQ * 512 + qh * 64,
                                  nullptr, sinks[qh] * LOG2E, qb * 256, tlo, 4 * qb + 4);
            }
        }
    }
    xcd_barrier(bar);

    {
        { pg8::Gemm g{OA, WA, M, D, 512}; pg8::StaticOrder S; S.init(M, D, G, bx); pg8::EpiBranch<false> E{MERGED, PROJ + 2304};
          pg8::gemm_phase<pg8::EpiBranch<false>, pg8::StaticOrder, true, true>(lds, g, S, E); }
        { pg8::Gemm g{OB, WB, M, D, 512}; pg8::StaticOrder S; S.init(M, D, G, bx); pg8::EpiBranch<true> E{MERGED, PROJ + 2304 + 1024};
          pg8::gemm_phase<pg8::EpiBranch<true>, pg8::StaticOrder, true, true>(lds, g, S, E); }
    }
    xcd_barrier(bar);

    {
        pg8::Gemm g{MERGED, WOUT, M, D, D}; pg8::StaticOrder S; S.init(M, D, G, bx); pg8::EpiF32 E{Y, D};
        pg8::gemm_phase<pg8::EpiF32, pg8::StaticOrder, true, true>(lds, g, S, E);
    }
    xcd_barrier(bar);

    for (int row = gw; row < M; row += NGW) {
        const int b = row / SEQ;
        const float* ada = ADA + b * (NADA * D);
        const f32x4* yr = (const f32x4*)(Y + (size_t)row * D) + lane;
        const f32x4* xr = (const f32x4*)(x + (size_t)row * D) + lane;
        f32x4* orow = (f32x4*)(out + (size_t)row * D) + lane;
        f32x4 v[4]; float ss = 0.f;
#pragma unroll
        for (int j = 0; j < 4; ++j) { v[j] = yr[64 * j]; ss += (v[j][0] * v[j][0] + v[j][1] * v[j][1]) + (v[j][2] * v[j][2] + v[j][3] * v[j][3]); }
        const float rstd = 1.0f / sqrtf(wave_sum(ss) * (1.0f / D) + RMS_EPS);
        float s2 = 0.f;
#pragma unroll
        for (int j = 0; j < 4; ++j) {
            const int cidx = 4 * (lane + 64 * j);
            const f32x4 g = *(const f32x4*)(g_post_mix + cidx), gt = *(const f32x4*)(ada + 2 * D + cidx);
            v[j] = xr[64 * j] + gt * (v[j] * rstd * g);
            orow[64 * j] = v[j];
            s2 += (v[j][0] * v[j][0] + v[j][1] * v[j][1]) + (v[j][2] * v[j][2] + v[j][3] * v[j][3]);
        }
        const float rstd2 = 1.0f / sqrtf(wave_sum(s2) * (1.0f / D) + RMS_EPS);
        unsigned long long* o8 = (unsigned long long*)(H2 + (size_t)row * D) + lane;
#pragma unroll
        for (int j = 0; j < 4; ++j) {
            const int cidx = 4 * (lane + 64 * j);
            const f32x4 g = *(const f32x4*)(g_pre_ffn + cidx), sc = *(const f32x4*)(ada + 4 * D + cidx), sh = *(const f32x4*)(ada + 3 * D + cidx);
            const f32x4 hv = v[j] * rstd2 * g * (sc + 1.0f) + sh;
            o8[64 * j] = (unsigned long long)pk2(hv[0], hv[1]) | ((unsigned long long)pk2(hv[2], hv[3]) << 32);
        }
    }
    xcd_barrier(bar);

    {
        pg8::Gemm g{H2, WFI, M, 2 * DFF, D}; pg8::StaticOrder S; S.init(M, 2 * DFF, G, bx); pg8::EpiSwiglu E{ACT, DFF};
        pg8::gemm_phase<pg8::EpiSwiglu, pg8::StaticOrder, true, true>(lds, g, S, E);
    }
    xcd_barrier(bar);

    {
        pg8::Gemm g{ACT, WFO, M, D, DFF}; pg8::StaticOrder S; S.init(M, D, G, bx); pg8::EpiF32 E{Y2, D};
        pg8::gemm_phase<pg8::EpiF32, pg8::StaticOrder, true, true>(lds, g, S, E);
    }
    xcd_barrier(bar);

    for (int row = gw; row < M; row += NGW) {
        const int b = row / SEQ;
        const float* ada = ADA + b * (NADA * D);
        const f32x4* yr = (const f32x4*)(Y2 + (size_t)row * D) + lane;
        f32x4* orow = (f32x4*)(out + (size_t)row * D) + lane;
        f32x4 v[4]; float ss = 0.f;
#pragma unroll
        for (int j = 0; j < 4; ++j) { v[j] = yr[64 * j]; ss += (v[j][0] * v[j][0] + v[j][1] * v[j][1]) + (v[j][2] * v[j][2] + v[j][3] * v[j][3]); }
        const float rstd = 1.0f / sqrtf(wave_sum(ss) * (1.0f / D) + RMS_EPS);
#pragma unroll
        for (int j = 0; j < 4; ++j) {
            const int cidx = 4 * (lane + 64 * j);
            const f32x4 g = *(const f32x4*)(g_post_ffn + cidx), gt = *(const f32x4*)(ada + 5 * D + cidx);
            orow[64 * j] = orow[64 * j] + gt * (v[j] * rstd * g);
        }
    }
}

extern "C" void kernel_launch(void* const* d_in, const int* in_sizes, int n_in, void* d_out, int out_size, void* d_ws, size_t ws_size, hipStream_t stream) {
    static int grid = 0;
    if (grid == 0) {
        if (n_in != 17 || in_sizes[0] != M * D || out_size != M * D || ws_size < WS_END) { fprintf(stderr, "kernel_launch: unexpected shapes (n_in %d, in0 %d, out %d, ws %zu)\n", n_in, n_in > 0 ? in_sizes[0] : -1, out_size, ws_size); grid = -1; return; }
        int dev = 0, cus = 0, per_cu = 0;
        if (hipGetDevice(&dev) != hipSuccess || hipDeviceGetAttribute(&cus, hipDeviceAttributeMultiprocessorCount, dev) != hipSuccess) { grid = -1; return; }
        if (hipFuncSetAttribute((const void*)mega_fwd, hipFuncAttributeMaxDynamicSharedMemorySize, LDS_BYTES) != hipSuccess) { fprintf(stderr, "kernel_launch: hipFuncSetAttribute failed\n"); grid = -1; return; }
        if (hipOccupancyMaxActiveBlocksPerMultiprocessor(&per_cu, (const void*)mega_fwd, NTHR, LDS_BYTES) != hipSuccess || per_cu < 1) { fprintf(stderr, "kernel_launch: occupancy query says %d\n", per_cu); per_cu = 1; }
        (void)hipGetLastError();
        grid = cus * 1;
    }
    if (grid < 0) return;
    Args a{};
    for (int i = 0; i < 17; ++i) a.in[i] = d_in[i];
    a.out = (float*)d_out; a.ws = (unsigned char*)d_ws;
    void* kargs[] = {&a};
    hipError_t e = hipLaunchCooperativeKernel((const void*)mega_fwd, dim3(grid), dim3(NTHR), kargs, LDS_BYTES, stream);
    if (e != hipSuccess) fprintf(stderr, "kernel_launch: cooperative launch failed: %s (grid %d)\n", hipGetErrorString(e), grid);
}
```

```cpp
#include <hip/hip_runtime.h>
#include <hip/hip_cooperative_groups.h>
#include <cstdio>
#include <cstdint>
#include <cmath>
namespace cg = cooperative_groups;
namespace pg8 {
#define PG8_LAS __attribute__((address_space(3)))
typedef unsigned short bf16_t;
typedef short bf16x8 __attribute__((ext_vector_type(8)));
typedef float f32x4 __attribute__((ext_vector_type(4)));
typedef unsigned u32x4 __attribute__((ext_vector_type(4)));
constexpr int BM = 256, BK = 64, HALF = 128, HTB = HALF * BK * 2  , STAGE_BYTES = 8 * HTB, NXCD = 8, WGM = 8;

__host__ __device__ __forceinline__ int lds_byte(int r, int c) { const int st = (r >> 4) * 2 + (c >> 5), rr = r & 15, cc = c & 31, ob = rr * 64 + cc * 2; return st * 1024 + (ob ^ (((ob >> 9) & 1) << 5)); }
__host__ __device__ __forceinline__ void stage_rc(int b, int& R, int& C) { const int st = b / 1024, sb = b % 1024, swz = sb ^ (((sb >> 9) & 1) << 5); R = (st >> 1) * 16 + swz / 64; C = (st & 1) * 32 + (swz % 64) / 2; }
__host__ __device__ __forceinline__ int perm32(int rho) { const int n = rho >> 4, i = rho & 15; return 8 * (i >> 2) + 4 * n + (i & 3); }

struct Unit { int pm, pn; };
struct Gemm { const bf16_t* A; const bf16_t* Bt; int M, N, K; };

struct StaticOrder {
    int nM, nN, nwg, G, c;
    __host__ __device__ void init(int M, int N, int G_, int c_) { nM = M / BM; nN = N / BM; nwg = nM * nN; G = G_; c = c_; }
    __host__ __device__ bool next(int i, Unit& u) const {
        const long L = (long)i * G + c; if (L >= nwg) return false;
        int wgid = (int)L; { const int q = nwg / NXCD, r = nwg % NXCD, xcd = wgid % NXCD, off = wgid / NXCD; wgid = (xcd < r ? xcd * (q + 1) : r * (q + 1) + (xcd - r) * q) + off; }
        const int nig = WGM * nN, gid = wgid / nig, fm = gid * WGM, gsz = (nM - fm) < WGM ? (nM - fm) : WGM;
        u.pm = fm + ((wgid % nig) % gsz); u.pn = (wgid % nig) / gsz; return true;
    }
    __device__ __forceinline__ void a_ready(const Unit&) const {}
    __device__ __forceinline__ void done(const Unit&) const {}
};
__device__ __forceinline__ unsigned cvt_pk_bf16(float lo, float hi) { unsigned r; asm volatile("v_cvt_pk_bf16_f32 %0, %1, %2" : "=v"(r) : "v"(lo), "v"(hi)); return r; }
typedef float f32x2 __attribute__((ext_vector_type(2)));
typedef unsigned u32x2 __attribute__((ext_vector_type(2)));
constexpr int PROJ_W = 4352;
constexpr float QSCALE = 0.125f * 1.4426950408889634f;
__device__ __forceinline__ float sigmoidf_(float v) { return 1.0f / (1.0f + __expf(-v)); }

struct EpiProj {
    static constexpr bool PERM = true, AFTER_DRAIN = false;
    bf16_t* P; const float* cs; const float* sn;
    __device__ __forceinline__ void operator()(const f32x4 (&acc)[2][2][4][2], const Unit& u, int wr, int wc, int fr, int fq) const {
        const int row0 = u.pm * BM + wr * 64 + fr;
#pragma unroll
        for (int bj = 0; bj < 2; ++bj) {
            const int ht = u.pn * 2 + bj;
            if (ht < 5) {
                const float sc = ht < 4 ? QSCALE : 1.0f;
                const int g4 = 4 * (4 * (wc & 1) + fq);
                const int cb = ht * 128 + (wc >> 1) * 64 + g4;
#pragma unroll
                for (int ai = 0; ai < 2; ++ai)
#pragma unroll
                    for (int m = 0; m < 4; ++m) {
                        const int row = row0 + ai * HALF + m * 16;
                        const f32x4 c = *(const f32x4*)(cs + (size_t)row * 32 + g4), s = *(const f32x4*)(sn + (size_t)row * 32 + g4);
                        const f32x4 x1 = acc[ai][bj][m][0], x2 = acc[ai][bj][m][1];
                        const f32x4 o1 = (x1 * c - x2 * s) * sc, o2 = (x2 * c + x1 * s) * sc;
                        u32x2 w1, w2; w1.x = cvt_pk_bf16(o1[0], o1[1]); w1.y = cvt_pk_bf16(o1[2], o1[3]); w2.x = cvt_pk_bf16(o2[0], o2[1]); w2.y = cvt_pk_bf16(o2[2], o2[3]);
                        bf16_t* rp = P + (size_t)row * PROJ_W + cb;
                        *(u32x2*)rp = w1; *(u32x2*)(rp + 32) = w2;
                    }
            } else {
                const int mode = (ht >= 18) ? 2 : ((ht >= 6 && ht < 10) ? 1 : 0);
                const float sc = mode == 1 ? QSCALE : 1.0f;
                const int col0 = ht * 128 + wc * 32 + 8 * fq;
#pragma unroll
                for (int ai = 0; ai < 2; ++ai)
#pragma unroll
                    for (int m = 0; m < 4; ++m) {
                        const int row = row0 + ai * HALF + m * 16;
                        f32x4 v0 = acc[ai][bj][m][0], v1 = acc[ai][bj][m][1];
                        if (mode == 2) {
#pragma unroll
                            for (int j = 0; j < 4; ++j) { v0[j] = sigmoidf_(v0[j]); v1[j] = sigmoidf_(v1[j]); }
                        } else { v0 = v0 * sc; v1 = v1 * sc; }
                        u32x4 w; w.x = cvt_pk_bf16(v0[0], v0[1]); w.y = cvt_pk_bf16(v0[2], v0[3]); w.z = cvt_pk_bf16(v1[0], v1[1]); w.w = cvt_pk_bf16(v1[2], v1[3]);
                        *(u32x4*)(P + (size_t)row * PROJ_W + col0) = w;
                    }
            }
        }
    }
};
__device__ __forceinline__ float bf_lo(unsigned w) { return __uint_as_float(w << 16); }
__device__ __forceinline__ float bf_hi(unsigned w) { return __uint_as_float(w & 0xffff0000u); }
template <bool SECOND> struct EpiBranch {
    static constexpr bool PERM = true, AFTER_DRAIN = false;
    bf16_t* O; const bf16_t* G;
    __device__ __forceinline__ void operator()(const f32x4 (&acc)[2][2][4][2], const Unit& u, int wr, int wc, int fr, int fq) const {
        const int row0 = u.pm * BM + wr * 64 + fr, col0 = u.pn * BM + wc * 32 + 8 * fq;
#pragma unroll
        for (int ai = 0; ai < 2; ++ai)
#pragma unroll
            for (int m = 0; m < 4; ++m) {
                const int row = row0 + ai * HALF + m * 16;
#pragma unroll
                for (int bj = 0; bj < 2; ++bj) {
                    const int col = col0 + bj * HALF;
                    const u32x4 g = *(const u32x4*)(G + (size_t)row * PROJ_W + col);
                    f32x4 v0 = acc[ai][bj][m][0], v1 = acc[ai][bj][m][1];
                    v0[0] *= bf_lo(g.x); v0[1] *= bf_hi(g.x); v0[2] *= bf_lo(g.y); v0[3] *= bf_hi(g.y);
                    v1[0] *= bf_lo(g.z); v1[1] *= bf_hi(g.z); v1[2] *= bf_lo(g.w); v1[3] *= bf_hi(g.w);
                    bf16_t* op = O + (size_t)row * 1024 + col;
                    if (SECOND) { const u32x4 p = *(const u32x4*)op;
                        v0[0] += bf_lo(p.x); v0[1] += bf_hi(p.x); v0[2] += bf_lo(p.y); v0[3] += bf_hi(p.y);
                        v1[0] += bf_lo(p.z); v1[1] += bf_hi(p.z); v1[2] += bf_lo(p.w); v1[3] += bf_hi(p.w); }
                    u32x4 w; w.x = cvt_pk_bf16(v0[0], v0[1]); w.y = cvt_pk_bf16(v0[2], v0[3]); w.z = cvt_pk_bf16(v1[0], v1[1]); w.w = cvt_pk_bf16(v1[2], v1[3]);
                    *(u32x4*)op = w;
                }
            }
    }
};
struct EpiF32 {
    static constexpr bool PERM = true, AFTER_DRAIN = false;
    float* O; int ldc;
    __device__ __forceinline__ void operator()(const f32x4 (&acc)[2][2][4][2], const Unit& u, int wr, int wc, int fr, int fq) const {
        const int row0 = u.pm * BM + wr * 64 + fr, col0 = u.pn * BM + wc * 32 + 8 * fq;
#pragma unroll
        for (int ai = 0; ai < 2; ++ai)
#pragma unroll
            for (int m = 0; m < 4; ++m) {
                float* rp = O + (size_t)(row0 + ai * HALF + m * 16) * ldc + col0;
#pragma unroll
                for (int bj = 0; bj < 2; ++bj) { *(f32x4*)(rp + bj * HALF) = acc[ai][bj][m][0]; *(f32x4*)(rp + bj * HALF + 4) = acc[ai][bj][m][1]; }
            }
    }
};
struct EpiSwiglu {
    static constexpr bool PERM = true, AFTER_DRAIN = false;
    bf16_t* O; int ldc;
    __device__ __forceinline__ void operator()(const f32x4 (&acc)[2][2][4][2], const Unit& u, int wr, int wc, int fr, int fq) const {
        const int row0 = u.pm * BM + wr * 64 + fr, col0 = u.pn * HALF + wc * 32 + 8 * fq;
#pragma unroll
        for (int ai = 0; ai < 2; ++ai)
#pragma unroll
            for (int m = 0; m < 4; ++m) {
                f32x4 v0, v1;
#pragma unroll
                for (int j = 0; j < 4; ++j) { const float g0 = acc[ai][0][m][0][j], g1 = acc[ai][0][m][1][j];
                    v0[j] = g0 * sigmoidf_(g0) * acc[ai][1][m][0][j]; v1[j] = g1 * sigmoidf_(g1) * acc[ai][1][m][1][j]; }
                u32x4 w; w.x = cvt_pk_bf16(v0[0], v0[1]); w.y = cvt_pk_bf16(v0[2], v0[3]); w.z = cvt_pk_bf16(v1[0], v1[1]); w.w = cvt_pk_bf16(v1[2], v1[3]);
                *(u32x4*)(O + (size_t)(row0 + ai * HALF + m * 16) * ldc + col0) = w;
            }
    }
};
template <class Epi, class Sched, bool ALIGN_EPI = false, bool SP2 = false>
__device__ __forceinline__ void gemm_phase(PG8_LAS unsigned char* lds, const Gemm g, const Sched& S, const Epi& E) {
    const int tid = threadIdx.x, wid = __builtin_amdgcn_readfirstlane(tid >> 6), lane = tid & 63, wr = wid >> 2, wc = wid & 3, fr = lane & 15, fq = lane >> 4;
    const int K = g.K, nt = K / BK;
    unsigned voffA[2], voffB[2];
#pragma unroll
    for (int i = 0; i < 2; ++i) { int R, C; stage_rc(tid * 16 + i * 8192, R, C); const int Rb = Epi::PERM ? ((R & ~31) + perm32(R & 31)) : R;
        voffA[i] = (unsigned)(R * K + C) * 2u; voffB[i] = (unsigned)(Rb * K + C) * 2u; }
    const size_t kstep = (size_t)(BK * 2);
    const size_t hstep = (size_t)HALF * K * 2;
    const size_t tstep = 2 * hstep;
    const unsigned ldsw = (unsigned)wid * 1024u;
    const int aoff = lds_byte(wr * 64 + fr, fq * 8), boff = lds_byte(wc * 32 + fr, fq * 8);
#define PG8_SA(b, h) (((b) * 2 + (h)) * HTB)
#define PG8_SB(b, h) ((4 + (b) * 2 + (h)) * HTB)
#define PG8_STAGE(bufoff, gbase, voff) do { _Pragma("unroll") for (int _i = 0; _i < 2; ++_i) \
        __builtin_amdgcn_global_load_lds((const unsigned*)((const char*)(gbase) + (voff)[_i]), (PG8_LAS unsigned*)(lds + (bufoff) + ldsw + _i * 8192), 16, 0, 0); } while (0)
#define PG8_LDA(dst, b, h) do { _Pragma("unroll") for (int m = 0; m < 4; ++m) _Pragma("unroll") for (int k = 0; k < 2; ++k) dst[m][k] = *(const PG8_LAS bf16x8*)(lds + PG8_SA(b, h) + aoff + m * 2048 + k * 1024); } while (0)
#define PG8_LDB(dst, b, h) do { _Pragma("unroll") for (int n = 0; n < 2; ++n) _Pragma("unroll") for (int k = 0; k < 2; ++k) dst[n][k] = *(const PG8_LAS bf16x8*)(lds + PG8_SB(b, h) + boff + n * 2048 + k * 1024); } while (0)
#define PG8_MMA(ai, bj, At, Bt) do { __builtin_amdgcn_s_setprio(1); _Pragma("unroll") for (int m = 0; m < 4; ++m) _Pragma("unroll") for (int n = 0; n < 2; ++n) _Pragma("unroll") for (int k = 0; k < 2; ++k) \
        acc[ai][bj][m][n] = __builtin_amdgcn_mfma_f32_16x16x32_bf16(Bt[n][k], At[m][k], acc[ai][bj][m][n], 0, 0, 0); __builtin_amdgcn_s_setprio(0); } while (0)
#define PG8_WAIT_V(n) asm volatile("s_waitcnt vmcnt(" #n ")" ::: "memory")
#define PG8_WAIT_L(n) asm volatile("s_waitcnt lgkmcnt(" #n ")" ::: "memory")
#define PG8_BAR __builtin_amdgcn_s_barrier()
#define PG8_SCHED __builtin_amdgcn_sched_barrier(0)
    Unit cur, nxt; int ui = 0;
    if (!S.next(0, cur)) return;
    f32x4 acc[2][2][4][2];
#pragma unroll
    for (int a = 0; a < 2; ++a)
#pragma unroll
        for (int b = 0; b < 2; ++b)
#pragma unroll
            for (int m = 0; m < 4; ++m)
#pragma unroll
                for (int n = 0; n < 2; ++n) acc[a][b][m][n] = (f32x4){0.f, 0.f, 0.f, 0.f};
    bf16x8 At[4][2], B0[2][2], B1[2][2];
    const char* cA = (const char*)g.A + (size_t)cur.pm * tstep; const char* cB = (const char*)g.Bt + (size_t)cur.pn * tstep;
    S.a_ready(cur);
    if constexpr (SP2) {
        PG8_STAGE(PG8_SB(0, 0), cB, voffB); PG8_STAGE(PG8_SB(0, 1), cB + hstep, voffB); PG8_STAGE(PG8_SA(0, 0), cA, voffA); PG8_STAGE(PG8_SA(0, 1), cA + hstep, voffA);
        if (wr == 1) PG8_BAR;
        PG8_WAIT_V(2); PG8_BAR;
        PG8_STAGE(PG8_SB(1, 0), cB + kstep, voffB); PG8_STAGE(PG8_SA(1, 0), cA + kstep, voffA); PG8_STAGE(PG8_SB(1, 1), cB + hstep + kstep, voffB);
        PG8_WAIT_V(6); PG8_BAR;
    } else {
        PG8_STAGE(PG8_SB(0, 0), cB, voffB); PG8_STAGE(PG8_SA(0, 0), cA, voffA); PG8_STAGE(PG8_SB(0, 1), cB + hstep, voffB); PG8_STAGE(PG8_SA(0, 1), cA + hstep, voffA);
        if (wr == 1) PG8_BAR;
        PG8_WAIT_V(4); PG8_BAR;
        PG8_STAGE(PG8_SB(1, 0), cB + kstep, voffB); PG8_STAGE(PG8_SA(1, 0), cA + kstep, voffA); PG8_STAGE(PG8_SB(1, 1), cB + hstep + kstep, voffB);
        PG8_WAIT_V(6); PG8_BAR;
    }
    for (;;) {
        const bool has_next = S.next(ui + 1, nxt);
        const char* nA = has_next ? (const char*)g.A + (size_t)nxt.pm * tstep : cA; const char* nB = has_next ? (const char*)g.Bt + (size_t)nxt.pn * tstep : cB;
        for (int t = 0; t < nt; t += 2) {
            const bool last = (t == nt - 2);
            const char* a1 = cA + (size_t)(t + 1) * kstep;
            const char* a2 = last ? nA : cA + (size_t)(t + 2) * kstep; const char* b2 = last ? nB : cB + (size_t)(t + 2) * kstep;
            const char* a3 = a2 + kstep; const char* b3 = b2 + kstep;
            if (last && has_next) S.a_ready(nxt);
            if constexpr (SP2) {
            PG8_LDB(B0, 0, 0); PG8_LDB(B1, 0, 1); PG8_SCHED; PG8_LDA(At, 0, 0); PG8_STAGE(PG8_SA(1, 1), a1 + hstep, voffA);
            PG8_WAIT_V(8); PG8_WAIT_L(0); PG8_BAR; PG8_MMA(0, 0, At, B0); PG8_MMA(0, 1, At, B1); PG8_BAR; PG8_SCHED;
            PG8_LDA(At, 0, 1); PG8_STAGE(PG8_SB(0, 0), b2, voffB); PG8_STAGE(PG8_SB(0, 1), b2 + hstep, voffB); PG8_STAGE(PG8_SA(0, 0), a2, voffA);
            PG8_WAIT_V(8); PG8_WAIT_L(0); PG8_BAR; PG8_MMA(1, 0, At, B0); PG8_MMA(1, 1, At, B1); PG8_BAR; PG8_SCHED;
            PG8_LDB(B0, 1, 0); PG8_LDB(B1, 1, 1); PG8_SCHED; PG8_LDA(At, 1, 0); PG8_STAGE(PG8_SA(0, 1), a2 + hstep, voffA);
            PG8_WAIT_V(8); PG8_WAIT_L(0); PG8_BAR; PG8_MMA(0, 0, At, B0); PG8_MMA(0, 1, At, B1); PG8_BAR; PG8_SCHED;
            PG8_LDA(At, 1, 1); PG8_STAGE(PG8_SB(1, 0), b3, voffB); PG8_STAGE(PG8_SB(1, 1), b3 + hstep, voffB); PG8_STAGE(PG8_SA(1, 0), a3, voffA);
            PG8_WAIT_V(8); PG8_WAIT_L(0); PG8_BAR; PG8_MMA(1, 0, At, B0); PG8_MMA(1, 1, At, B1); PG8_BAR; PG8_SCHED;
            } else {
            PG8_LDB(B0, 0, 0); PG8_SCHED; PG8_LDA(At, 0, 0); PG8_STAGE(PG8_SA(1, 1), a1 + hstep, voffA);
            PG8_WAIT_L(8); PG8_BAR; PG8_WAIT_L(0); PG8_MMA(0, 0, At, B0); PG8_BAR; PG8_SCHED;
            PG8_LDB(B1, 0, 1); PG8_STAGE(PG8_SB(0, 0), b2, voffB);
            PG8_BAR; PG8_WAIT_L(0); PG8_MMA(0, 1, At, B1); PG8_BAR;
            PG8_LDA(At, 0, 1); PG8_STAGE(PG8_SA(0, 0), a2, voffA);
            PG8_BAR; PG8_WAIT_L(0); PG8_MMA(1, 0, At, B0); PG8_BAR; PG8_SCHED;
            PG8_STAGE(PG8_SB(0, 1), b2 + hstep, voffB);
            PG8_WAIT_V(6); PG8_BAR; PG8_MMA(1, 1, At, B1); PG8_BAR;
            PG8_LDB(B0, 1, 0); PG8_SCHED; PG8_LDA(At, 1, 0); PG8_STAGE(PG8_SA(0, 1), a2 + hstep, voffA);
            PG8_WAIT_L(8); PG8_BAR; PG8_WAIT_L(0); PG8_MMA(0, 0, At, B0); PG8_BAR; PG8_SCHED;
            PG8_LDB(B1, 1, 1); PG8_STAGE(PG8_SB(1, 0), b3, voffB);
            PG8_BAR; PG8_WAIT_L(0); PG8_MMA(0, 1, At, B1); PG8_BAR;
            PG8_LDA(At, 1, 1); PG8_STAGE(PG8_SA(1, 0), a3, voffA);
            PG8_BAR; PG8_WAIT_L(0); PG8_MMA(1, 0, At, B0); PG8_BAR; PG8_SCHED;
            PG8_STAGE(PG8_SB(1, 1), b3 + hstep, voffB);
            PG8_WAIT_V(6); PG8_BAR; PG8_MMA(1, 1, At, B1); PG8_BAR;
            }
        }
        if constexpr (ALIGN_EPI) { if (wr == 0) PG8_BAR; }
        if constexpr (!Epi::AFTER_DRAIN) { E(acc, cur, wr, wc, fr, fq); S.done(cur); }
        if (!has_next) break;
#pragma unroll
        for (int a = 0; a < 2; ++a)
#pragma unroll
            for (int b = 0; b < 2; ++b)
#pragma unroll
                for (int m = 0; m < 4; ++m)
#pragma unroll
                    for (int n = 0; n < 2; ++n) acc[a][b][m][n] = (f32x4){0.f, 0.f, 0.f, 0.f};
        cur = nxt; cA = nA; cB = nB; ++ui;
        if constexpr (ALIGN_EPI) { if (wr == 1) PG8_BAR; }
    }
    PG8_WAIT_V(0);
    if constexpr (!ALIGN_EPI) { if (wr == 0) PG8_BAR; }
    PG8_BAR;
    if constexpr (Epi::AFTER_DRAIN) { E.fused(acc, cur, wr, wc, fr, fq, lds, wid, lane); S.done(cur); }
#undef PG8_SA
#undef PG8_SB
#undef PG8_STAGE
#undef PG8_LDA
#undef PG8_LDB
#undef PG8_MMA
#undef PG8_WAIT_V
#undef PG8_WAIT_L
#undef PG8_BAR
#undef PG8_SCHED
}
}

namespace att {
#define ALAS __attribute__((address_space(3)))
typedef unsigned short bf16;
typedef short bf16x8 __attribute__((ext_vector_type(8)));
typedef short s16x4 __attribute__((ext_vector_type(4)));
typedef float f32x16 __attribute__((ext_vector_type(16)));
typedef float f32x4 __attribute__((ext_vector_type(4)));
typedef float f32x2 __attribute__((ext_vector_type(2)));
typedef __bf16 bf16x2_t __attribute__((ext_vector_type(2)));
typedef unsigned u32x4 __attribute__((ext_vector_type(4)));
typedef unsigned u32x2 __attribute__((ext_vector_type(2)));
constexpr int PITCH = 4352, OPITCH = 512, BUFB = 16640;
__device__ __forceinline__ unsigned cvtpk(float lo, float hi) { f32x2 v = {lo, hi}; bf16x2_t b = __builtin_convertvector(v, bf16x2_t); return __builtin_bit_cast(unsigned, b); }
__device__ __forceinline__ s16x4 vtr(const ALAS unsigned char* p) { return __builtin_bit_cast(s16x4, __builtin_amdgcn_ds_read_tr16_b64_v4i16((ALAS s16x4*)p)); }
__device__ __forceinline__ int crow(int i, int h) { return (i & 3) + 8 * (i >> 2) + 4 * h; }

template <int MODE>
__device__ __forceinline__ void attn_unit(ALAS unsigned char* shm, const bf16* Qp, const bf16* Kp, const bf16* Vp, bf16* Op, const float* biasp, float m_init, int q0, int t_lo, int t_hi) {
    const int tid = threadIdx.x, lane = tid & 63, r = lane & 31, h = lane >> 5;
    const int wid = __builtin_amdgcn_readfirstlane(tid >> 6);
    const int qw0 = q0 + wid * 32, qrow = qw0 + r;
    const bf16* ksrc = Kp + (size_t)lane * PITCH + wid * 8;
    const bf16* vsrc = Vp + (size_t)(16 * (wid & 3) + (lane >> 2)) * PITCH + (wid >> 2) * 32 + (lane & 3) * 8;
    const int sdst = wid * 1024 + lane * 16;
    bf16x8 qr[4];
#pragma unroll
    for (int d0 = 0; d0 < 4; ++d0) qr[d0] = *(const bf16x8*)(Qp + (size_t)qrow * PITCH + d0 * 16 + h * 8);
    f32x16 o0, o1;
#pragma unroll
    for (int i = 0; i < 16; ++i) { o0[i] = 0.f; o1[i] = 0.f; }
    float m = m_init, l = (MODE == 1 && h == 0) ? 1.0f : 0.0f;
    if (MODE == 0) {
        const ALAS float* kmax2 = (const ALAS float*)(shm + 2 * BUFB);
        ALAS float* sc = (ALAS float*)(shm + 2 * BUFB + 256);
        float n2 = 0.f;
#pragma unroll
        for (int d0 = 0; d0 < 4; ++d0)
#pragma unroll
            for (int e = 0; e < 8; ++e) { const float v = __uint_as_float(((unsigned)(unsigned short)qr[d0][e]) << 16); n2 += v * v; }
        n2 += __shfl_xor(n2, 32);
#pragma unroll
        for (int o = 1; o < 32; o <<= 1) n2 = fmaxf(n2, __shfl_xor(n2, o));
        if (lane == 0) sc[wid] = n2;
        __syncthreads();
        if (wid == 0) {
            float qm2 = sc[0];
#pragma unroll
            for (int w = 1; w < 8; ++w) qm2 = fmaxf(qm2, sc[w]);
            const float qm = sqrtf(qm2) * 1.001f;
            const int tq = q0 >> 6;
            const float kd2 = fmaxf(fmaxf(kmax2[tq], kmax2[tq + 1]), fmaxf(kmax2[tq + 2], kmax2[tq + 3]));
            const float L = biasp[q0] - qm * sqrtf(kd2) * 1.001f - 48.0f;
            bool keep = false;
            if (lane < t_hi) keep = !(biasp[64 * lane + 63] + qm * sqrtf(kmax2[lane]) * 1.001f < L);
            const unsigned long long mk = __ballot(keep);
            const int tl = mk ? (int)__builtin_ctzll(mk) : 0;
            if (lane == 0) ((ALAS int*)sc)[8] = tl;
        }
        __syncthreads();
        t_lo = ((const ALAS int*)sc)[8];
    }
    u32x4 kreg, vreg; float breg = 0.f;
    kreg = *(const u32x4*)(ksrc + (size_t)t_lo * 64 * PITCH); vreg = *(const u32x4*)(vsrc + (size_t)t_lo * 64 * PITCH);
    if (MODE == 0 && tid < 64) breg = biasp[t_lo * 64 + tid];
    *(ALAS u32x4*)(shm + sdst) = kreg; *(ALAS u32x4*)(shm + 8192 + sdst) = vreg;
    if (MODE == 0 && tid < 64) *(ALAS float*)(shm + 16384 + tid * 4) = breg;
    __syncthreads();
    const int nt = t_hi - t_lo;
    for (int it = 0; it < nt; ++it) {
        const int t = t_lo + it;
        ALAS unsigned char* buf = shm + (it & 1) * BUFB;
        const bool more = it + 1 < nt;
        if (more) { kreg = *(const u32x4*)(ksrc + (size_t)(t + 1) * 64 * PITCH); vreg = *(const u32x4*)(vsrc + (size_t)(t + 1) * 64 * PITCH);
                    if (MODE == 0 && tid < 64) breg = biasp[(t + 1) * 64 + tid]; }
        const int k0 = t * 64;
        const bool need = (k0 <= qw0 + 31) && (MODE == 0 || (k0 + 63 >= qw0 - 127));
        if (need) {
            f32x16 s0, s1;
#pragma unroll
            for (int i = 0; i < 16; ++i) { s0[i] = 0.f; s1[i] = 0.f; }
#pragma unroll
            for (int d0 = 0; d0 < 4; ++d0) {
                const bf16x8 ka = *(const ALAS bf16x8*)(buf + (2 * d0 + h) * 1024 + r * 16);
                const bf16x8 kb = *(const ALAS bf16x8*)(buf + (2 * d0 + h) * 1024 + (32 + r) * 16);
                s0 = __builtin_amdgcn_mfma_f32_32x32x16_bf16(ka, qr[d0], s0, 0, 0, 0);
                s1 = __builtin_amdgcn_mfma_f32_32x32x16_bf16(kb, qr[d0], s1, 0, 0, 0);
            }
            if (MODE == 0) {
#pragma unroll
                for (int g = 0; g < 4; ++g) {
                    const f32x4 b0 = *(const ALAS f32x4*)(buf + 16384 + (8 * g + 4 * h) * 4), b1 = *(const ALAS f32x4*)(buf + 16384 + (32 + 8 * g + 4 * h) * 4);
#pragma unroll
                    for (int j = 0; j < 4; ++j) { s0[4 * g + j] += b0[j]; s1[4 * g + j] += b1[j]; }
                }
            }
            const bool boundary = (MODE == 1) || (k0 + 63 > qw0);
            if (boundary) {
#pragma unroll
                for (int i = 0; i < 16; ++i) {
                    const int ka0 = k0 + crow(i, h), ka1 = ka0 + 32;
                    const bool v0 = (ka0 <= qrow) && (MODE == 0 || (qrow - ka0 < 128));
                    const bool v1 = (ka1 <= qrow) && (MODE == 0 || (qrow - ka1 < 128));
                    s0[i] = v0 ? s0[i] : -INFINITY; s1[i] = v1 ? s1[i] : -INFINITY;
                }
            }
            float mx = fmaxf(s0[0], s1[0]);
#pragma unroll
            for (int i = 1; i < 16; ++i) mx = fmaxf(mx, fmaxf(s0[i], s1[i]));
            mx = fmaxf(mx, __shfl_xor(mx, 32));
            const float mn = fmaxf(m, mx);
            const float alpha = __builtin_amdgcn_exp2f(m - mn);
            m = mn;
            float ps = 0.f;
#pragma unroll
            for (int i = 0; i < 16; ++i) { s0[i] = __builtin_amdgcn_exp2f(s0[i] - mn); s1[i] = __builtin_amdgcn_exp2f(s1[i] - mn); ps += s0[i] + s1[i]; }
            l = l * alpha + ps;
#pragma unroll
            for (int i = 0; i < 16; ++i) { o0[i] *= alpha; o1[i] *= alpha; }
            const ALAS unsigned char* vb = buf + 8192 + (4 * h + ((lane & 15) >> 2)) * 64 + ((lane >> 4) & 1) * 32 + (lane & 3) * 8;
#pragma unroll
            for (int sb = 0; sb < 2; ++sb)
#pragma unroll
                for (int ks = 0; ks < 2; ++ks) {
                    u32x4 pw;
                    if (sb == 0) { pw.x = cvtpk(s0[8 * ks + 0], s0[8 * ks + 1]); pw.y = cvtpk(s0[8 * ks + 2], s0[8 * ks + 3]); pw.z = cvtpk(s0[8 * ks + 4], s0[8 * ks + 5]); pw.w = cvtpk(s0[8 * ks + 6], s0[8 * ks + 7]); }
                    else         { pw.x = cvtpk(s1[8 * ks + 0], s1[8 * ks + 1]); pw.y = cvtpk(s1[8 * ks + 2], s1[8 * ks + 3]); pw.z = cvtpk(s1[8 * ks + 4], s1[8 * ks + 5]); pw.w = cvtpk(s1[8 * ks + 6], s1[8 * ks + 7]); }
                    const bf16x8 pf = __builtin_bit_cast(bf16x8, pw);
                    const ALAS unsigned char* vp = vb + (32 * sb + 16 * ks) * 64;
                    const s16x4 a0 = vtr(vp), a1 = vtr(vp + 512), c0 = vtr(vp + 4096), c1 = vtr(vp + 4096 + 512);
                    const bf16x8 vf0 = {a0[0], a0[1], a0[2], a0[3], a1[0], a1[1], a1[2], a1[3]};
                    const bf16x8 vf1 = {c0[0], c0[1], c0[2], c0[3], c1[0], c1[1], c1[2], c1[3]};
                    o0 = __builtin_amdgcn_mfma_f32_32x32x16_bf16(vf0, pf, o0, 0, 0, 0);
                    o1 = __builtin_amdgcn_mfma_f32_32x32x16_bf16(vf1, pf, o1, 0, 0, 0);
                }
        }
        if (more) {
            ALAS unsigned char* nb = shm + ((it + 1) & 1) * BUFB;
            *(ALAS u32x4*)(nb + sdst) = kreg; *(ALAS u32x4*)(nb + 8192 + sdst) = vreg;
            if (MODE == 0 && tid < 64) *(ALAS float*)(nb + 16384 + tid * 4) = breg;
        }
        __syncthreads();
    }
    const float lt = l + __shfl_xor(l, 32);
    const float inv = 1.0f / lt;
    bf16* orow = Op + (size_t)qrow * OPITCH;
#pragma unroll
    for (int g = 0; g < 4; ++g) {
        u32x2 w0, w1;
        w0.x = cvtpk(o0[4 * g + 0] * inv, o0[4 * g + 1] * inv); w0.y = cvtpk(o0[4 * g + 2] * inv, o0[4 * g + 3] * inv);
        w1.x = cvtpk(o1[4 * g + 0] * inv, o1[4 * g + 1] * inv); w1.y = cvtpk(o1[4 * g + 2] * inv, o1[4 * g + 3] * inv);
        *(u32x2*)(orow + 8 * g + 4 * h) = w0; *(u32x2*)(orow + 32 + 8 * g + 4 * h) = w1;
    }
}
}
#define GAS __attribute__((address_space(1)))
#define LAS __attribute__((address_space(3)))
typedef unsigned short bf16;
typedef unsigned v4u __attribute__((ext_vector_type(4)));
typedef float f32x4 __attribute__((ext_vector_type(4)));
constexpr int NWAVES = 8, NTHR = NWAVES * 64;
constexpr int BATCH = 8, SEQ = 4096, D = 1024, M = BATCH * SEQ, DFF = 2816, INW = 4360, PROJW = 4352, NADA = 6;
constexpr float RMS_EPS = 1e-6f, LOG2E = 1.4426950408889634f;
constexpr size_t MiB = 1u << 20;
constexpr size_t WS_ADA = 1 * MiB;
constexpr size_t WS_WF = WS_ADA + 256 * 1024;
constexpr size_t WS_LOGF = 2 * MiB;
constexpr size_t WS_CUM = 3 * MiB;
constexpr size_t WS_COS = 4 * MiB, WS_SIN = 8 * MiB;
constexpr size_t WS_WIN = 12 * MiB;
constexpr size_t WS_WA = 21 * MiB, WS_WB = 22 * MiB;
constexpr size_t WS_WOUT = 23 * MiB;
constexpr size_t WS_WFI = 25 * MiB;
constexpr size_t WS_WFO = 36 * MiB;
constexpr size_t WS_H = 48 * MiB;
constexpr size_t WS_MERGED = 112 * MiB;
constexpr size_t WS_PROJ = 176 * MiB;
constexpr size_t WS_END = 448 * MiB;
constexpr int LDS_BYTES = 147456;

__device__ __forceinline__ unsigned f2bf(float f) { unsigned u = __builtin_bit_cast(unsigned, f); return (u + 0x7fffu + ((u >> 16) & 1u)) >> 16; }
__device__ __forceinline__ unsigned pk2(float lo, float hi) { return f2bf(lo) | (f2bf(hi) << 16); }
__device__ __forceinline__ float wave_sum(float v) {
#pragma unroll
    for (int o = 1; o < 64; o <<= 1) v += __shfl_xor(v, o);
    return v;
}
#define XB_TMO      128
#define XB_XCNT(j)  (256  + 64 * (j))
#define XB_XSUB(j)  (1280 + 64 * (j))
#define XB_XGEN(j)  (2304 + 64 * (j))
#define XB_TOP      3328
#define XB_TOPGEN   3392
#define XCD_BAR_WORDS 3456
#define XB_SPIN_CAP (1u << 18)

__device__ __forceinline__ unsigned xb_ld(unsigned* p)              { return __hip_atomic_load(p, __ATOMIC_RELAXED, __HIP_MEMORY_SCOPE_AGENT); }
__device__ __forceinline__ unsigned xb_add(unsigned* p, unsigned v) { return __hip_atomic_fetch_add(p, v, __ATOMIC_RELAXED, __HIP_MEMORY_SCOPE_AGENT); }
__device__ __forceinline__ unsigned xb_xcc_id() { return (unsigned)__builtin_amdgcn_s_getreg((3 << 11) | 20) & 0xFu; }
#define XB_SPIN(cond, bar) do { unsigned _sp = 0; while (cond) { __builtin_amdgcn_s_sleep(1); \
    if ((++_sp & 255u) == 0u) { if (xb_ld(&(bar)[XB_TMO])) break; if (_sp > XB_SPIN_CAP) { atomicAdd(&(bar)[XB_TMO], 1u); break; } } } } while (0)

struct XcdBarrier {
    unsigned* bar; unsigned x;
    volatile LAS unsigned* st;
};

__device__ __forceinline__ XcdBarrier xcd_barrier_post(unsigned* bar, volatile LAS unsigned* st) {
    XcdBarrier b; b.bar = bar; b.x = xb_xcc_id(); b.st = st;
    if (threadIdx.x == 0) (void)xb_add(&bar[XB_XCNT(b.x)], 1u);
    return b;
}
__device__ __forceinline__ void xcd_barrier_complete(unsigned* bar, unsigned x, unsigned& nloc, unsigned& nx) {
    const unsigned G = gridDim.x * gridDim.y * gridDim.z;
    unsigned sum, cnt, mine, sp = 0u;
    for (;;) {
        sum = 0u; cnt = 0u; mine = 0u;
#pragma unroll
        for (unsigned j = 0; j < 16; ++j) { const unsigned c = xb_ld(&bar[XB_XCNT(j)]); sum += c; cnt += (c > 0u) ? 1u : 0u; mine = (j == x) ? c : mine; }
        if (sum == G) break;
        __builtin_amdgcn_s_sleep(1);
        if ((++sp & 255u) == 0u) { if (xb_ld(&bar[XB_TMO])) break; if (sp > XB_SPIN_CAP) { atomicAdd(&bar[XB_TMO], 1u); break; } }
    }
    nloc = mine > 0u ? mine : 1u; nx = cnt > 0u ? cnt : 1u;
}

__device__ __forceinline__ void xcd_barrier(const XcdBarrier& b) {
    asm volatile("s_waitcnt vmcnt(0)" ::: "memory");
    __syncthreads();
    if (threadIdx.x == 0) {
        unsigned* bar = b.bar;
        __builtin_amdgcn_s_waitcnt(0);
        unsigned nloc = b.st[0], nx = b.st[1];
        if (nloc == 0u) { xcd_barrier_complete(bar, b.x, nloc, nx); b.st[0] = nloc; b.st[1] = nx; }
        const unsigned old = xb_add(&bar[XB_XSUB(b.x)], 1u);
        const unsigned gen = old / nloc;
        if (old + 1u == (gen + 1u) * nloc) {
            __builtin_amdgcn_fence(__ATOMIC_RELEASE, "agent");
            asm volatile("s_waitcnt vmcnt(0)" ::: "memory");
            const unsigned og = xb_add(&bar[XB_TOP], 1u);
            const unsigned tg = og / nx;
            if (og + 1u == (tg + 1u) * nx) xb_add(&bar[XB_TOPGEN], 1u);
            else XB_SPIN(xb_ld(&bar[XB_TOPGEN]) == tg, bar);
            __builtin_amdgcn_fence(__ATOMIC_ACQUIRE, "agent");
            xb_add(&bar[XB_XGEN(b.x)], 1u);
            asm volatile("s_waitcnt vmcnt(0)" ::: "memory");
        } else {
            XB_SPIN(xb_ld(&bar[XB_XGEN(b.x)]) == gen, bar);
            __builtin_amdgcn_fence(__ATOMIC_ACQUIRE, "agent");
            asm volatile("s_waitcnt vmcnt(0)" ::: "memory");
        }
    }
    __syncthreads();
}

template <class CM>
__device__ __forceinline__ void transpose_item(const float* W, int K, int ldw, int Nst, bf16* WT, LAS float* scr, int item, int lane, CM cm) {
    const int nblk = Nst / 32, kb = item / nblk, nb = item % nblk, k0 = 64 * kb, n0 = 32 * nb;
    const int sc = cm(n0 + (lane & 31));
#pragma unroll 8
    for (int i = 0; i < 32; ++i) { const int kk = 2 * i + (lane >> 5); scr[kk * 33 + (lane & 31)] = W[(size_t)(k0 + kk) * ldw + sc]; }
    asm volatile("s_waitcnt lgkmcnt(0)" ::: "memory");
    const int c = lane & 7;
#pragma unroll
    for (int j = 0; j < 4; ++j) { const int n = (lane >> 3) + 8 * j; const LAS float* s = scr + (8 * c) * 33 + n;
        v4u o; o.x = pk2(s[0 * 33], s[1 * 33]); o.y = pk2(s[2 * 33], s[3 * 33]); o.z = pk2(s[4 * 33], s[5 * 33]); o.w = pk2(s[6 * 33], s[7 * 33]);
        *(v4u*)(WT + (size_t)(n0 + n) * K + k0 + 8 * c) = o; }
    asm volatile("s_waitcnt lgkmcnt(0)" ::: "memory");
}
struct CmId { __device__ __forceinline__ int operator()(int n) const { return n; } };
struct CmWin { __device__ __forceinline__ int operator()(int n) const {
    if (n < 640) { const int p = n & 63, g = p >> 3, e = p & 7; return (n & ~63) + ((e < 4) ? (4 * g + e) : (32 + 4 * g + (e - 4))); }
    return n < 2304 ? n : n + 8; } };
struct CmFfn { __device__ __forceinline__ int operator()(int n) const { const int t = n >> 8, w = n & 255; return (w < 128) ? (128 * t + w) : (DFF + 128 * t + (w - 128)); } };

struct Args { const void* in[17]; float* out; unsigned char* ws; };

__device__ __forceinline__ float log_sigmoid_(float z) { return z >= 0.f ? -log1pf(__expf(-z)) : z - log1pf(__expf(z)); }

__global__ void __launch_bounds__(NTHR, 2) mega_fwd(Args args) {
    extern __shared__ __attribute__((aligned(16))) unsigned char lds_raw[];
    LAS unsigned char* lds = (LAS unsigned char*)lds_raw;
    cg::grid_group grid = cg::this_grid();
    const int tid = threadIdx.x, lane = tid & 63, wave = __builtin_amdgcn_readfirstlane(tid >> 6);
    const int G = gridDim.x, bx = blockIdx.x;
    const int vcu = (G % 8 == 0) ? (bx % 8) * (G / 8) + bx / 8 : bx;
    const int gw = vcu * NWAVES + wave, NGW = G * NWAVES;
    unsigned char* ws = args.ws;
    const float* x = (const float*)args.in[0]; const float* cvec = (const float*)args.in[1]; const int* positions = (const int*)args.in[2];
    const float* w_ada = (const float*)args.in[3]; const float* b_ada = (const float*)args.in[4];
    const float* g_pre_mix = (const float*)args.in[5]; const float* g_post_mix = (const float*)args.in[6];
    const float* w_in = (const float*)args.in[7]; const float* b_f = (const float*)args.in[8]; const float* sinks = (const float*)args.in[9];
    const float* w_branch_a = (const float*)args.in[10]; const float* w_branch_b = (const float*)args.in[11]; const float* w_out = (const float*)args.in[12];
    const float* g_pre_ffn = (const float*)args.in[13]; const float* g_post_ffn = (const float*)args.in[14];
    const float* w_ffn_in = (const float*)args.in[15]; const float* w_ffn_out = (const float*)args.in[16];
    float* out = args.out;
    float* ADA = (float*)(ws + WS_ADA); float* WF = (float*)(ws + WS_WF); float* LOGF = (float*)(ws + WS_LOGF); float* CUM = (float*)(ws + WS_CUM);
    float* COS = (float*)(ws + WS_COS); float* SIN = (float*)(ws + WS_SIN);
    bf16* WIN = (bf16*)(ws + WS_WIN); bf16* WA = (bf16*)(ws + WS_WA); bf16* WB = (bf16*)(ws + WS_WB); bf16* WOUT = (bf16*)(ws + WS_WOUT);
    bf16* WFI = (bf16*)(ws + WS_WFI); bf16* WFO = (bf16*)(ws + WS_WFO);
    bf16* H = (bf16*)(ws + WS_H); bf16* OA = (bf16*)(ws + WS_H); bf16* OB = OA + (size_t)M * 512; bf16* H2 = (bf16*)(ws + WS_H); float* Y2 = (float*)(ws + WS_H);
    bf16* MERGED = (bf16*)(ws + WS_MERGED);
    bf16* PROJ = (bf16*)(ws + WS_PROJ); float* Y = (float*)(ws + WS_PROJ); bf16* ACT = (bf16*)(ws + WS_PROJ);

    volatile LAS unsigned* MISC = (volatile LAS unsigned*)(lds + 131072 + 320);
    if (tid < 32) MISC[tid] = 0u;
    unsigned* barw = (unsigned*)ws;
    if (bx == 0) for (int i = tid; i < XCD_BAR_WORDS; i += NTHR) barw[i] = 0u;
    __syncthreads();
    {
        LAS float* cl = (LAS float*)lds;
        LAS float* part = (LAS float*)(lds + 32768);
        for (int i = tid; i < 8 * 1024; i += NTHR) { const int b = i >> 10, k = i & 1023; cl[k * 8 + b] = cvec[i]; }
        __syncthreads();
        for (int ch = vcu; ch < 256; ch += G) {
            const int n0 = 24 * ch;
            if (tid < 504) {
                const int col = tid % 24, kg = tid / 24;
                float a[8];
#pragma unroll
                for (int b = 0; b < 8; ++b) a[b] = 0.f;
                for (int k = kg; k < 1024; k += 21) {
                    const float w = w_ada[(size_t)k * (NADA * D) + n0 + col];
                    const f32x4 c0 = *(const LAS f32x4*)(cl + k * 8), c1 = *(const LAS f32x4*)(cl + k * 8 + 4);
                    a[0] += w * c0[0]; a[1] += w * c0[1]; a[2] += w * c0[2]; a[3] += w * c0[3];
                    a[4] += w * c1[0]; a[5] += w * c1[1]; a[6] += w * c1[2]; a[7] += w * c1[3];
                }
#pragma unroll
                for (int b = 0; b < 8; ++b) part[(kg * 24 + col) * 8 + b] = a[b];
            }
            __syncthreads();
            if (tid < 192) {
                const int col = tid >> 3, b = tid & 7; float s = b_ada[n0 + col];
                for (int kg = 0; kg < 21; ++kg) s += part[(kg * 24 + col) * 8 + b];
                ADA[b * (NADA * D) + n0 + col] = s;
            }
            __syncthreads();
        }
        LAS float* scr = (LAS float*)(lds + wave * 16384);
        constexpr int I_IN = (D / 64) * (PROJW / 32), I_A = (512 / 64) * (D / 32), I_O = (D / 64) * (D / 32), I_FI = (D / 64) * (2 * DFF / 32), I_FO = (DFF / 64) * (D / 32);
        constexpr int NITEMS = I_IN + 2 * I_A + I_O + I_FI + I_FO;
        for (int it = gw; it < NITEMS; it += NGW) {
            int r = it;
            if (r < I_IN) { transpose_item(w_in, D, INW, PROJW, WIN, scr, r, lane, CmWin()); continue; } r -= I_IN;
            if (r < I_A) { transpose_item(w_branch_a, 512, D, D, WA, scr, r, lane, CmId()); continue; } r -= I_A;
            if (r < I_A) { transpose_item(w_branch_b, 512, D, D, WB, scr, r, lane, CmId()); continue; } r -= I_A;
            if (r < I_O) { transpose_item(w_out, D, D, D, WOUT, scr, r, lane, CmId()); continue; } r -= I_O;
            if (r < I_FI) { transpose_item(w_ffn_in, D, 2 * DFF, 2 * DFF, WFI, scr, r, lane, CmFfn()); continue; } r -= I_FI;
            transpose_item(w_ffn_out, DFF, D, D, WFO, scr, r, lane, CmId());
        }
        for (int i = vcu * NTHR + tid; i < 8 * 1024; i += G * NTHR) { const int j = i >> 10, k = i & 1023; WF[i] = w_in[(size_t)k * INW + 2304 + j]; }
        for (int i = vcu * NTHR + tid; i < M * 32; i += G * NTHR) {
            const int row = i >> 5, f = i & 31;
            const double inv_freq = exp(-(double)f * (9.210340371976184 / 32.0));
            const double ang = (double)positions[row] * inv_freq;
            const double qd = rint(ang * 0.6366197723675814);
            const double rr = fma(-qd, 1.5707963267948966, ang) - qd * 6.123233995736766e-17;
            const double r2 = rr * rr;
            const double sp = rr * (1.0 + r2 * (-1.0 / 6 + r2 * (1.0 / 120 + r2 * (-1.0 / 5040 + r2 * (1.0 / 362880 + r2 * (-1.0 / 39916800 + r2 * (1.0 / 6227020800.0)))))));
            const double cp = 1.0 + r2 * (-0.5 + r2 * (1.0 / 24 + r2 * (-1.0 / 720 + r2 * (1.0 / 40320 + r2 * (-1.0 / 3628800 + r2 * (1.0 / 479001600.0 + r2 * (-1.0 / 87178291200.0)))))));
            const int qi = ((int)qd) & 3;
            const double sv = (qi == 0) ? sp : (qi == 1) ? cp : (qi == 2) ? -sp : -cp;
            const double cv = (qi == 0) ? cp : (qi == 1) ? -sp : (qi == 2) ? -cp : sp;
            COS[i] = (float)cv; SIN[i] = (float)sv;
        }
    }
    grid.sync();
    XcdBarrier bar = xcd_barrier_post(barw, MISC + 8);

    {
        LAS float* wf = (LAS float*)lds;
        for (int i = tid; i < 8 * 1024; i += NTHR) wf[i] = WF[i];
        __syncthreads();
        for (int row = gw; row < M; row += NGW) {
            const int b = row / SEQ;
            const f32x4* xr = (const f32x4*)(x + (size_t)row * D) + lane;
            const float* ada = ADA + b * (NADA * D);
            f32x4 v[4]; float ss = 0.f;
#pragma unroll
            for (int j = 0; j < 4; ++j) { v[j] = xr[64 * j]; ss += (v[j][0] * v[j][0] + v[j][1] * v[j][1]) + (v[j][2] * v[j][2] + v[j][3] * v[j][3]); }
            const float rstd = 1.0f / sqrtf(wave_sum(ss) * (1.0f / D) + RMS_EPS);
            float fl[8];
#pragma unroll
            for (int jj = 0; jj < 8; ++jj) fl[jj] = 0.f;
            unsigned long long* o8 = (unsigned long long*)(H + (size_t)row * D) + lane;
#pragma unroll
            for (int j = 0; j < 4; ++j) {
                const int cidx = 4 * (lane + 64 * j);
                const f32x4 g = *(const f32x4*)(g_pre_mix + cidx), sc = *(const f32x4*)(ada + 1 * D + cidx), sh = *(const f32x4*)(ada + 0 * D + cidx);
                const f32x4 hv = v[j] * rstd * g * (sc + 1.0f) + sh;
#pragma unroll
                for (int jj = 0; jj < 8; ++jj) { const f32x4 w = *(const LAS f32x4*)(wf + jj * 1024 + cidx); fl[jj] += (hv[0] * w[0] + hv[1] * w[1]) + (hv[2] * w[2] + hv[3] * w[3]); }
                o8[64 * j] = (unsigned long long)pk2(hv[0], hv[1]) | ((unsigned long long)pk2(hv[2], hv[3]) << 32);
            }
            float mine = 0.f;
#pragma unroll
            for (int jj = 0; jj < 8; ++jj) { const float s = wave_sum(fl[jj]); if (lane == jj) mine = s; }
            if (lane < 8) LOGF[(size_t)row * 8 + lane] = log_sigmoid_(mine + b_f[lane]);
        }
    }
    xcd_barrier(bar);

    {
        LAS float* wt = (LAS float*)lds;
        for (int bh = bx; bh < BATCH * 8; bh += G) {
            const int b = bh >> 3, hh = bh & 7;
            float vals[8]; float run = 0.f;
#pragma unroll
            for (int e = 0; e < 8; ++e) { run += LOGF[((size_t)b * SEQ + tid * 8 + e) * 8 + hh]; vals[e] = run; }
            float inc = run;
#pragma unroll
            for (int o = 1; o < 64; o <<= 1) { const float nb = __shfl_up(inc, o); if (lane >= o) inc += nb; }
            if (lane == 63) wt[wave] = inc;
            __syncthreads();
            float base = inc - run;
            for (int w = 0; w < wave; ++w) base += wt[w];
#pragma unroll
            for (int e = 0; e < 8; ++e) CUM[(size_t)bh * SEQ + tid * 8 + e] = -(base + vals[e]) * LOG2E;
            __syncthreads();
        }
        pg8::Gemm g{H, WIN, M, PROJW, D}; pg8::StaticOrder S; S.init(M, PROJW, G, bx);
        pg8::EpiProj E{PROJ, COS, SIN};
        pg8::gemm_phase<pg8::EpiProj, pg8::StaticOrder, true, true>(lds, g, S, E);
    }
    xcd_barrier(bar);

    {
        for (int j = vcu; j < 256; j += G) {
            const int bh = j >> 2, s = j & 3, b = bh >> 3, hh = bh & 7;
            const bf16* base = PROJ + (size_t)b * SEQ * PROJW;
            {
                __syncthreads();
                const bf16* kb = base + 1280 + hh * 64; float mx = 0.f;
#pragma unroll 2
                for (int e = 0; e < 8; ++e) {
                    const v4u* p = (const v4u*)(kb + (size_t)(tid * 8 + e) * PROJW); float sq = 0.f;
#pragma unroll
                    for (int c = 0; c < 8; ++c) { const v4u w = p[c];
#pragma unroll
                        for (int q = 0; q < 4; ++q) { const float lo = __uint_as_float(w[q] << 16), hi = __uint_as_float(w[q] & 0xffff0000u); sq += lo * lo + hi * hi; } }
                    mx = fmaxf(mx, sq);
                }
                mx = fmaxf(mx, __shfl_xor(mx, 1)); mx = fmaxf(mx, __shfl_xor(mx, 2)); mx = fmaxf(mx, __shfl_xor(mx, 4));
                if ((tid & 7) == 0) ((LAS float*)(lds + 2 * att::BUFB))[tid >> 3] = mx;
                __syncthreads();
            }
#pragma unroll 1
            for (int k = 0; k < 4; ++k) {
                const int qb = (k == 0) ? 15 - s : (k == 1) ? 8 + s : (k == 2) ? 7 - s : s;
                att::attn_unit<0>(lds, base + 768 + hh * 64, base + 1280 + hh * 64, base + 1792 + hh * 64, OB + (size_t)b * SEQ * 512 + hh * 64,
                                  CUM + (size_t)bh * SEQ, -1e30f, qb * 256, 0, 4 * qb + 4);
            }
        }
        for (int j = vcu; j < 256; j += G) {
#pragma unroll 1
            for (int k = 0; k < 4; ++k) {
                const int u = 4 * j + k, qb = u & 15, qh = (u >> 4) & 7, b = u >> 7;
                const bf16* base = PROJ + (size_t)b * SEQ * PROJW;
                const int tlo = (4 * qb - 2) > 0 ? (4 * qb - 2) : 0;
                att::attn_unit<1>(lds, base + qh * 64, base + 512 + (qh >> 2) * 64, base + 640 + (qh >> 2) * 64, OA + (size_t)b * SEQ * 512 + qh * 64,
                                  nullptr, sinks[qh] * LOG2E, qb * 256, tlo, 4 * qb + 4);
            }
        }
    }
    xcd_barrier(bar);

    {
        { pg8::Gemm g{OA, WA, M, D, 512}; pg8::StaticOrder S; S.init(M, D, G, bx); pg8::EpiBranch<false> E{MERGED, PROJ + 2304};
          pg8::gemm_phase<pg8::EpiBranch<false>, pg8::StaticOrder, true, true>(lds, g, S, E); }
        { pg8::Gemm g{OB, WB, M, D, 512}; pg8::StaticOrder S; S.init(M, D, G, bx); pg8::EpiBranch<true> E{MERGED, PROJ + 2304 + 1024};
          pg8::gemm_phase<pg8::EpiBranch<true>, pg8::StaticOrder, true, true>(lds, g, S, E); }
    }
    xcd_barrier(bar);

    {
        pg8::Gemm g{MERGED, WOUT, M, D, D}; pg8::StaticOrder S; S.init(M, D, G, bx); pg8::EpiF32 E{Y, D};
        pg8::gemm_phase<pg8::EpiF32, pg8::StaticOrder, true, true>(lds, g, S, E);
    }
    xcd_barrier(bar);

    for (int row = gw; row < M; row += NGW) {
        const int b = row / SEQ;
        const float* ada = ADA + b * (NADA * D);
        const f32x4* yr = (const f32x4*)(Y + (size_t)row * D) + lane;
        const f32x4* xr = (const f32x4*)(x + (size_t)row * D) + lane;
        f32x4* orow = (f32x4*)(out + (size_t)row * D) + lane;
        f32x4 v[4]; float ss = 0.f;
#pragma unroll
        for (int j = 0; j < 4; ++j) { v[j] = yr[64 * j]; ss += (v[j][0] * v[j][0] + v[j][1] * v[j][1]) + (v[j][2] * v[j][2] + v[j][3] * v[j][3]); }
        const float rstd = 1.0f / sqrtf(wave_sum(ss) * (1.0f / D) + RMS_EPS);
        float s2 = 0.f;
#pragma unroll
        for (int j = 0; j < 4; ++j) {
            const int cidx = 4 * (lane + 64 * j);
            const f32x4 g = *(const f32x4*)(g_post_mix + cidx), gt = *(const f32x4*)(ada + 2 * D + cidx);
            v[j] = xr[64 * j] + gt * (v[j] * rstd * g);
            orow[64 * j] = v[j];
            s2 += (v[j][0] * v[j][0] + v[j][1] * v[j][1]) + (v[j][2] * v[j][2] + v[j][3] * v[j][3]);
        }
        const float rstd2 = 1.0f / sqrtf(wave_sum(s2) * (1.0f / D) + RMS_EPS);
        unsigned long long* o8 = (unsigned long long*)(H2 + (size_t)row * D) + lane;
#pragma unroll
        for (int j = 0; j < 4; ++j) {
            const int cidx = 4 * (lane + 64 * j);
            const f32x4 g = *(const f32x4*)(g_pre_ffn + cidx), sc = *(const f32x4*)(ada + 4 * D + cidx), sh = *(const f32x4*)(ada + 3 * D + cidx);
            const f32x4 hv = v[j] * rstd2 * g * (sc + 1.0f) + sh;
            o8[64 * j] = (unsigned long long)pk2(hv[0], hv[1]) | ((unsigned long long)pk2(hv[2], hv[3]) << 32);
        }
    }
    xcd_barrier(bar);

    {
        pg8::Gemm g{H2, WFI, M, 2 * DFF, D}; pg8::StaticOrder S; S.init(M, 2 * DFF, G, bx); pg8::EpiSwiglu E{ACT, DFF};
        pg8::gemm_phase<pg8::EpiSwiglu, pg8::StaticOrder, true, true>(lds, g, S, E);
    }
    xcd_barrier(bar);

    {
        pg8::Gemm g{ACT, WFO, M, D, DFF}; pg8::StaticOrder S; S.init(M, D, G, bx); pg8::EpiF32 E{Y2, D};
        pg8::gemm_phase<pg8::EpiF32, pg8::StaticOrder, true, true>(lds, g, S, E);
    }
    xcd_barrier(bar);

    for (int row = gw; row < M; row += NGW) {
        const int b = row / SEQ;
        const float* ada = ADA + b * (NADA * D);
        const f32x4* yr = (const f32x4*)(Y2 + (size_t)row * D) + lane;
        f32x4* orow = (f32x4*)(out + (size_t)row * D) + lane;
        f32x4 v[4]; float ss = 0.f;
#pragma unroll
        for (int j = 0; j < 4; ++j) { v[j] = yr[64 * j]; ss += (v[j][0] * v[j][0] + v[j][1] * v[j][1]) + (v[j][2] * v[j][2] + v[j][3] * v[j][3]); }
        const float rstd = 1.0f / sqrtf(wave_sum(ss) * (1.0f / D) + RMS_EPS);
#pragma unroll
        for (int j = 0; j < 4; ++j) {
            const int cidx = 4 * (lane + 64 * j);
            const f32x4 g = *(const f32x4*)(g_post_ffn + cidx), gt = *(const f32x4*)(ada + 5 * D + cidx);
            orow[64 * j] = orow[64 * j] + gt * (v[j] * rstd * g);
        }
    }
}

extern "C" void kernel_launch(void* const* d_in, const int* in_sizes, int n_in, void* d_out, int out_size, void* d_ws, size_t ws_size, hipStream_t stream) {
    static int grid = 0;
    if (grid == 0) {
        if (n_in != 17 || in_sizes[0] != M * D || out_size != M * D || ws_size < WS_END) { fprintf(stderr, "kernel_launch: unexpected shapes (n_in %d, in0 %d, out %d, ws %zu)\n", n_in, n_in > 0 ? in_sizes[0] : -1, out_size, ws_size); grid = -1; return; }
        int dev = 0, cus = 0, per_cu = 0;
        if (hipGetDevice(&dev) != hipSuccess || hipDeviceGetAttribute(&cus, hipDeviceAttributeMultiprocessorCount, dev) != hipSuccess) { grid = -1; return; }
        if (hipFuncSetAttribute((const void*)mega_fwd, hipFuncAttributeMaxDynamicSharedMemorySize, LDS_BYTES) != hipSuccess) { fprintf(stderr, "kernel_launch: hipFuncSetAttribute failed\n"); grid = -1; return; }
        if (hipOccupancyMaxActiveBlocksPerMultiprocessor(&per_cu, (const void*)mega_fwd, NTHR, LDS_BYTES) != hipSuccess || per_cu < 1) { fprintf(stderr, "kernel_launch: occupancy query says %d\n", per_cu); per_cu = 1; }
        (void)hipGetLastError();
        grid = cus * 1;
    }
    if (grid < 0) return;
    Args a{};
    for (int i = 0; i < 17; ++i) a.in[i] = d_in[i];
    a.out = (float*)d_out; a.ws = (unsigned char*)d_ws;
    void* kargs[] = {&a};
    hipError_t e = hipLaunchCooperativeKernel((const void*)mega_fwd, dim3(grid), dim3(NTHR), kargs, LDS_BYTES, stream);
    if (e != hipSuccess) fprintf(stderr, "kernel_launch: cooperative launch failed: %s (grid %d)\n", hipGetErrorString(e), grid);
}
```
